# Optimizing an MI355X kernel written in HIP

```python
import math
import jax, jax.numpy as jnp
from jax import lax
import numpy as np

D_MODEL = 1024
BATCH = 2
SEQ = 16384
DEPTH = 4

N_MIXERS = 2
D_FF = 2816
HG_HEADS = 8
HG_KEY = D_MODEL // HG_HEADS
HG_VAL = D_MODEL // HG_HEADS
HG_CHUNK = 64
FOX_HEADS = 16
FOX_HEAD_DIM = D_MODEL // FOX_HEADS
Q_BLOCK = 128
N_HG_LAYERS = (DEPTH + 1) // 2
N_FOX_LAYERS = DEPTH // 2
EPS = 1e-6
MASK_VALUE = -1e30
MIN_GATE = 1e-30

kernel_name = "hgrn2_fox_macaron_interleaved"


def rmsnorm(x, g):
    x32 = x.astype(jnp.float32)
    y = x32 * lax.rsqrt(jnp.mean(x32 * x32, axis=-1, keepdims=True) + EPS)
    return (y * g.astype(jnp.float32)).astype(x.dtype)


def swiglu(h, w_in, w_out):
    gate, up = jnp.split(h @ w_in, 2, axis=-1)
    return (jax.nn.silu(gate) * up) @ w_out


def hgrn2_mixer(h, w_in, lb, out_norm_g, w_out):
    B, T, _ = h.shape
    C = HG_CHUNK
    n = T // C
    q, z_f, i, g = jnp.split(h @ w_in, 4, axis=-1)
    z32 = z_f.astype(jnp.float32)
    lb = lb.astype(jnp.float32)
    f = lb + (1.0 - lb) * jax.nn.sigmoid(z32)
    log_f = jnp.log(jnp.maximum(f, MIN_GATE))
    k = (1.0 - lb) * jax.nn.sigmoid(-z32)
    q = jax.nn.silu(q.astype(jnp.float32))
    v = i.astype(jnp.float32)

    def to_chunks(a, d):
        return a.reshape(B, n, C, HG_HEADS, d).transpose(1, 0, 3, 2, 4)

    qc, kc, lfc = to_chunks(q, HG_KEY), to_chunks(k, HG_KEY), to_chunks(log_f, HG_KEY)
    vc = to_chunks(v, HG_VAL)
    causal = jnp.tril(jnp.ones((C, C), dtype=bool))[:, :, None]

    def step(S, inp):
        qb, kb, vb, lb_c = inp
        b = jnp.cumsum(lb_c, axis=2)
        o_inter = jnp.einsum('bhtk,bhkv->bhtv', qb * jnp.exp(b), S)
        diff = b[:, :, :, None, :] - b[:, :, None, :, :]
        decay = jnp.where(causal, jnp.exp(jnp.where(causal, diff, 0.0)), 0.0)
        scores = jnp.einsum('bhtk,bhtsk,bhsk->bhts', qb, decay, kb)
        o_intra = jnp.einsum('bhts,bhsv->bhtv', scores, vb)
        b_last = b[:, :, -1:, :]
        k_dec = kb * jnp.exp(b_last - b)
        S_new = jnp.exp(b_last[:, :, 0, :])[..., None] * S + jnp.einsum('bhsk,bhsv->bhkv', k_dec, vb)
        return S_new, o_inter + o_intra

    S0 = jnp.zeros((B, HG_HEADS, HG_KEY, HG_VAL), jnp.float32)
    _, o = lax.scan(step, S0, (qc, kc, vc, lfc))
    o = o.transpose(1, 0, 3, 2, 4).reshape(B, T, HG_HEADS, HG_VAL)
    o = rmsnorm(o, out_norm_g).reshape(B, T, D_MODEL)
    o = o * jax.nn.silu(g.astype(jnp.float32))
    return o.astype(h.dtype) @ w_out


def fox_mixer(h, w_in, b_f, q_norm_g, k_norm_g, w_out):
    B, T, _ = h.shape
    H, Dh = FOX_HEADS, FOX_HEAD_DIM
    nb = T // Q_BLOCK
    D = D_MODEL
    proj = h @ w_in
    q, k, v, g, z_f = jnp.split(proj, [D, 2 * D, 3 * D, 4 * D], axis=-1)
    q = rmsnorm(q.reshape(B, T, H, Dh), q_norm_g).transpose(0, 2, 1, 3)
    k = rmsnorm(k.reshape(B, T, H, Dh), k_norm_g).transpose(0, 2, 1, 3)
    v = v.reshape(B, T, H, Dh).transpose(0, 2, 1, 3)
    log_f = jax.nn.log_sigmoid(z_f.astype(jnp.float32) + b_f.astype(jnp.float32))
    c = jnp.cumsum(log_f, axis=1).transpose(0, 2, 1)
    qb = q.reshape(B, H, nb, Q_BLOCK, Dh).transpose(2, 0, 1, 3, 4)
    cq = c.reshape(B, H, nb, Q_BLOCK).transpose(2, 0, 1, 3)
    scale = 1.0 / math.sqrt(Dh)
    key_pos = jnp.arange(T)

    def block(args):
        qi, cqi, start = args
        s = jnp.einsum('bhqd,bhkd->bhqk', qi, k).astype(jnp.float32) * scale
        s = s + cqi[..., None] - c[:, :, None, :]
        qpos = start + jnp.arange(Q_BLOCK)
        s = jnp.where(key_pos[None, :] <= qpos[:, None], s, MASK_VALUE)
        p = jax.nn.softmax(s, axis=-1)
        return jnp.einsum('bhqk,bhkd->bhqd', p.astype(v.dtype), v)

    o = lax.map(block, (qb, cq, jnp.arange(nb) * Q_BLOCK))
    o = o.transpose(1, 0, 3, 2, 4).reshape(B, T, D)
    o = o * jax.nn.sigmoid(g)
    return o @ w_out


def setup_inputs(seed: int = 0) -> dict:
    key = jax.random.key(seed)
    ks = jax.random.split(key, 16)
    f32 = jnp.float32
    D = D_MODEL

    def w(k, shape, fan_in):
        return jax.random.normal(k, shape, f32) * (fan_in ** -0.5)

    return {
        "x": jax.random.normal(ks[0], (BATCH, SEQ, D), f32),
        "norm_g": 1.0 + 0.05 * jax.random.normal(ks[1], (DEPTH, 3, D), f32),
        "ffn_w_in": w(ks[2], (DEPTH, 2, D, 2 * D_FF), D),
        "ffn_w_out": w(ks[3], (DEPTH, 2, D_FF, D), D_FF),
        "hg_w_in": w(ks[4], (N_HG_LAYERS, D, 4 * D), D),
        "hg_lb_logits": 0.5 * jax.random.normal(ks[5], (N_HG_LAYERS, HG_HEADS * HG_KEY), f32),
        "hg_out_norm_g": 1.0 + 0.05 * jax.random.normal(ks[6], (N_HG_LAYERS, HG_VAL), f32),
        "hg_w_out": w(ks[7], (N_HG_LAYERS, D, D), D),
        "fox_w_in": w(ks[8], (N_FOX_LAYERS, D, 4 * D + FOX_HEADS), D),
        "fox_b_f": 2.0 + 0.5 * jax.random.normal(ks[9], (N_FOX_LAYERS, FOX_HEADS), f32),
        "fox_q_norm_g": 1.0 + 0.05 * jax.random.normal(ks[10], (N_FOX_LAYERS, FOX_HEAD_DIM), f32),
        "fox_k_norm_g": 1.0 + 0.05 * jax.random.normal(ks[11], (N_FOX_LAYERS, FOX_HEAD_DIM), f32),
        "fox_w_out": w(ks[12], (N_FOX_LAYERS, D, D), D),
    }


def reference(x, norm_g, ffn_w_in, ffn_w_out, hg_w_in, hg_lb_logits, hg_out_norm_g, hg_w_out,
              fox_w_in, fox_b_f, fox_q_norm_g, fox_k_norm_g, fox_w_out):
    p = jax.nn.softmax(hg_lb_logits.astype(jnp.float32), axis=0)
    lbs = jnp.cumsum(p, axis=0) - p[0]
    for layer in range(DEPTH):
        j = layer // N_MIXERS
        x = x + 0.5 * swiglu(rmsnorm(x, norm_g[layer, 0]), ffn_w_in[layer, 0], ffn_w_out[layer, 0])
        hn = rmsnorm(x, norm_g[layer, 1])
        if layer % N_MIXERS == 0:
            x = x + hgrn2_mixer(hn, hg_w_in[j], lbs[j], hg_out_norm_g[j], hg_w_out[j])
        else:
            x = x + fox_mixer(hn, fox_w_in[j], fox_b_f[j], fox_q_norm_g[j], fox_k_norm_g[j], fox_w_out[j])
        x = x + 0.5 * swiglu(rmsnorm(x, norm_g[layer, 2]), ffn_w_in[layer, 1], ffn_w_out[layer, 1])
    return x
```

```cpp
#include <hip/hip_runtime.h>
#include <hip/hip_cooperative_groups.h>
#include <cstdio>
#include <cstdint>
namespace cg = cooperative_groups;
namespace pg8 {
#define PG8_LAS __attribute__((address_space(3)))
typedef unsigned short bf16_t;
typedef short bf16x8 __attribute__((ext_vector_type(8)));
typedef float f32x4 __attribute__((ext_vector_type(4)));
typedef unsigned u32x4 __attribute__((ext_vector_type(4)));
constexpr int BM = 256, BK = 64, HALF = 128, HTB = HALF * BK * 2  , STAGE_BYTES = 8 * HTB, NXCD = 8, WGM = 8;

__host__ __device__ __forceinline__ int lds_byte(int r, int c) { const int st = (r >> 4) * 2 + (c >> 5), rr = r & 15, cc = c & 31, ob = rr * 64 + cc * 2; return st * 1024 + (ob ^ (((ob >> 9) & 1) << 5)); }
__host__ __device__ __forceinline__ void stage_rc(int b, int& R, int& C) { const int st = b / 1024, sb = b % 1024, swz = sb ^ (((sb >> 9) & 1) << 5); R = (st >> 1) * 16 + swz / 64; C = (st & 1) * 32 + (swz % 64) / 2; }
__host__ __device__ __forceinline__ int perm32(int rho) { const int n = rho >> 4, i = rho & 15; return 8 * (i >> 2) + 4 * n + (i & 3); }

struct Unit { int pm, pn; };
struct Gemm { const bf16_t* A; const bf16_t* Bt; int M, N, K; };

struct StaticOrder {
    int nM, nN, nwg, G, c;
    __host__ __device__ void init(int M, int N, int G_, int c_) { nM = M / BM; nN = N / BM; nwg = nM * nN; G = G_; c = c_; }
    __host__ __device__ bool next(int i, Unit& u) const {
        const long L = (long)i * G + c; if (L >= nwg) return false;
        int wgid = (int)L; { const int q = nwg / NXCD, r = nwg % NXCD, xcd = wgid % NXCD, off = wgid / NXCD; wgid = (xcd < r ? xcd * (q + 1) : r * (q + 1) + (xcd - r) * q) + off; }
        const int nig = WGM * nN, gid = wgid / nig, fm = gid * WGM, gsz = (nM - fm) < WGM ? (nM - fm) : WGM;
        u.pm = fm + ((wgid % nig) % gsz); u.pn = (wgid % nig) / gsz; return true;
    }
    __device__ __forceinline__ void a_ready(const Unit&) const {}
    __device__ __forceinline__ void done(const Unit&) const {}
};

typedef float f32x2_cvt __attribute__((ext_vector_type(2))); typedef __bf16 bf16x2_cvt __attribute__((ext_vector_type(2)));
__device__ __forceinline__ unsigned cvt_pk_bf16(float lo, float hi) { const f32x2_cvt v = {lo, hi}; const bf16x2_cvt b = __builtin_convertvector(v, bf16x2_cvt); return __builtin_bit_cast(unsigned, b); }
typedef float f32x2 __attribute__((ext_vector_type(2)));
typedef float f32x2 __attribute__((ext_vector_type(2)));
constexpr float RMS_EPS = 1e-6f;
constexpr size_t BUF_STRIDE = (size_t)32 << 20;
constexpr float LOG2E = 1.4426950408889634f;
constexpr float FOX_C2 = 0.125f * 1.4426950408889634f;
__device__ __forceinline__ float fast_sigmoid(float x) { return __builtin_amdgcn_rcpf(1.0f + __builtin_amdgcn_exp2f(-x * LOG2E)); }
__device__ __forceinline__ float fast_silu(float x) { return x * fast_sigmoid(x); }
__device__ __forceinline__ f32x4 silu4(f32x4 v) { return (f32x4){fast_silu(v[0]), fast_silu(v[1]), fast_silu(v[2]), fast_silu(v[3])}; }
__device__ __forceinline__ f32x4 sigm4(f32x4 v) { return (f32x4){fast_sigmoid(v[0]), fast_sigmoid(v[1]), fast_sigmoid(v[2]), fast_sigmoid(v[3])}; }
__device__ __forceinline__ u32x4 pack8(f32x4 a, f32x4 b) { u32x4 w; w.x = cvt_pk_bf16(a[0], a[1]); w.y = cvt_pk_bf16(a[2], a[3]); w.z = cvt_pk_bf16(b[0], b[1]); w.w = cvt_pk_bf16(b[2], b[3]); return w; }
__device__ __forceinline__ float dot4(f32x4 a) { return (a[0] * a[0] + a[1] * a[1]) + (a[2] * a[2] + a[3] * a[3]); }
__device__ __forceinline__ float row_rs(const float* ssq, int row, int fq) {
    const f32x4 v = *(const f32x4*)(ssq + (size_t)row * 16 + 4 * fq);
    float s = (v[0] + v[1]) + (v[2] + v[3]);
    s += __shfl_xor(s, 16); s += __shfl_xor(s, 32);
    return __builtin_amdgcn_rsqf(s * (1.0f / 1024.0f) + RMS_EPS);
}
struct EpiSwiglu {
    static constexpr bool PERM = true, AFTER_DRAIN = false;
    bf16_t* H; const float* ssq; int ldh;
    __device__ __forceinline__ void operator()(const f32x4 (&acc)[2][2][4][2], const Unit& u, int wr, int wc, int fr_in, int fq_in) const {
        int fr = fr_in, fq = fq_in; asm volatile("" : "+v"(fr), "+v"(fq));
        const int row0 = u.pm * BM + wr * 64 + fr, col0 = u.pn * 128 + wc * 32 + 8 * fq;
#pragma unroll
        for (int ai = 0; ai < 2; ++ai)
#pragma unroll
            for (int m = 0; m < 4; ++m) {
                const int row = row0 + ai * HALF + m * 16; asm volatile("" ::: "memory"); const float rs = row_rs(ssq, row, fq);
                const f32x4 g0 = acc[ai][0][m][0] * rs, g1 = acc[ai][0][m][1] * rs, u0 = acc[ai][1][m][0] * rs, u1 = acc[ai][1][m][1] * rs;
                const f32x4 h0 = silu4(g0) * u0, h1 = silu4(g1) * u1;
                *(u32x4*)(H + (size_t)row * ldh + col0) = pack8(h0, h1);
            }
    }
};
struct EpiResid {
    static constexpr bool PERM = true, AFTER_DRAIN = false;
    const float* base; float* out; bf16_t* xb; float* ssq; float scale;
    __device__ __forceinline__ void operator()(const f32x4 (&acc)[2][2][4][2], const Unit& u, int wr, int wc, int fr_in, int fq_in) const {
        int fr = fr_in, fq = fq_in; asm volatile("" : "+v"(fr), "+v"(fq));
        const int row0 = u.pm * BM + wr * 64 + fr, col0 = u.pn * BM + wc * 32 + 8 * fq;
#pragma unroll
        for (int ai = 0; ai < 2; ++ai)
#pragma unroll
            for (int m = 0; m < 4; ++m) {
                asm volatile("" ::: "memory"); const int row = row0 + ai * HALF + m * 16; float ss = 0.f;
#pragma unroll
                for (int bj = 0; bj < 2; ++bj) {
                    const size_t off = (size_t)row * 1024 + col0 + bj * HALF;
                    const f32x4 b0 = *(const f32x4*)(base + off), b1 = *(const f32x4*)(base + off + 4);
                    const f32x4 o0 = b0 + acc[ai][bj][m][0] * scale, o1 = b1 + acc[ai][bj][m][1] * scale;
                    *(f32x4*)(out + off) = o0; *(f32x4*)(out + off + 4) = o1;
                    *(u32x4*)(xb + off) = pack8(o0, o1);
                    ss += dot4(o0) + dot4(o1);
                }
                ss += __shfl_xor(ss, 16); ss += __shfl_xor(ss, 32);
                if (fq == 0) ssq[(size_t)row * 16 + u.pn * 4 + wc] = ss;
            }
    }
};
__device__ __forceinline__ float logf1(float z, float a) { const float f = a + (1.0f - a) * fast_sigmoid(z); return __logf(fmaxf(f, 1e-30f)); }
__device__ __forceinline__ f32x4 logf4(f32x4 z, f32x4 a) { return (f32x4){logf1(z[0], a[0]), logf1(z[1], a[1]), logf1(z[2], a[2]), logf1(z[3], a[3])}; }
struct EpiHgrn {
    static constexpr bool PERM = true, AFTER_DRAIN = false;
    bf16_t* Q; float* LF; const float* lb; const float* ssq;
    __device__ __forceinline__ void operator()(const f32x4 (&acc)[2][2][4][2], const Unit& u, int wr, int wc, int fr_in, int fq_in) const {
        int fr = fr_in, fq = fq_in; asm volatile("" : "+v"(fr), "+v"(fq));
        const int sec = u.pn >> 2; const int row0 = u.pm * BM + wr * 64 + fr, cl0 = (u.pn & 3) * BM + wc * 32 + 8 * fq;
#pragma unroll
        for (int ai = 0; ai < 2; ++ai)
#pragma unroll
            for (int m = 0; m < 4; ++m) {
                const int row = row0 + ai * HALF + m * 16; asm volatile("" ::: "memory"); const float rs = row_rs(ssq, row, fq);
#pragma unroll
                for (int bj = 0; bj < 2; ++bj) {
                    f32x4 v0 = acc[ai][bj][m][0] * rs, v1 = acc[ai][bj][m][1] * rs; const size_t off = (size_t)row * 1024 + cl0 + bj * HALF;
                    if (sec == 1) {
                        const f32x4 la0 = *(const f32x4*)(lb + cl0 + bj * HALF), la1 = *(const f32x4*)(lb + cl0 + bj * HALF + 4);
                        const f32x4 l0 = logf4(v0, la0), l1 = logf4(v1, la1);
                        *(f32x4*)(LF + off) = l0; *(f32x4*)(LF + off + 4) = l1;
                    } else {
                        if (sec != 2) { v0 = silu4(v0); v1 = silu4(v1); }
                        bf16_t* dst = Q + (size_t)((sec == 0) ? 0 : (sec == 2) ? 1 : 2) * BUF_STRIDE;
                        *(u32x4*)(dst + off) = pack8(v0, v1);
                    }
                }
            }
    }
};
struct EpiFox {
    static constexpr bool PERM = true, AFTER_DRAIN = false;
    bf16_t* Q; float* LFX; const float *gq, *gk, *bfp; const float* ssq;
    __device__ __forceinline__ void operator()(const f32x4 (&acc)[2][2][4][2], const Unit& u, int wr, int wc, int fr_in, int fq_in) const {
        int fr = fr_in, fq = fq_in; asm volatile("" : "+v"(fr), "+v"(fq));
        const int row0 = u.pm * BM + wr * 64 + fr;
        if (u.pn < 16) {
            const int sec = u.pn >> 2; const int colh = (u.pn & 3) * BM + wc * 64 + 8 * fq;
            f32x4 gv[2][2];
#pragma unroll
            for (int bj = 0; bj < 2; ++bj)
#pragma unroll
                for (int n = 0; n < 2; ++n) {
                    const int d = 32 * bj + 8 * fq + 4 * n;
                    gv[bj][n] = (sec == 0) ? *(const f32x4*)(gq + d) * FOX_C2 : (sec == 1) ? *(const f32x4*)(gk + d) : (f32x4){1.f, 1.f, 1.f, 1.f};
                }
            bf16_t* dst = Q + (size_t)sec * BUF_STRIDE;
#pragma unroll
            for (int ai = 0; ai < 2; ++ai)
#pragma unroll
                for (int m = 0; m < 4; ++m) {
                    const int row = row0 + ai * HALF + m * 16; asm volatile("" ::: "memory"); const float rs = row_rs(ssq, row, fq);
                    f32x4 v[2][2]; float ss = 0.f;
#pragma unroll
                    for (int bj = 0; bj < 2; ++bj)
#pragma unroll
                        for (int n = 0; n < 2; ++n) { v[bj][n] = acc[ai][bj][m][n] * rs; ss += dot4(v[bj][n]); }
                    if (sec < 2) {
                        ss += __shfl_xor(ss, 16); ss += __shfl_xor(ss, 32);
                        const float sc = __builtin_amdgcn_rsqf(ss * (1.0f / 64.0f) + RMS_EPS);
#pragma unroll
                        for (int bj = 0; bj < 2; ++bj)
#pragma unroll
                            for (int n = 0; n < 2; ++n) v[bj][n] = v[bj][n] * sc * gv[bj][n];
                    } else if (sec == 3) {
#pragma unroll
                        for (int bj = 0; bj < 2; ++bj)
#pragma unroll
                            for (int n = 0; n < 2; ++n) v[bj][n] = sigm4(v[bj][n]);
                    }
#pragma unroll
                    for (int bj = 0; bj < 2; ++bj) *(u32x4*)(dst + (size_t)row * 1024 + colh + 32 * bj) = pack8(v[bj][0], v[bj][1]);
                }
        } else {
#pragma unroll
            for (int ai = 0; ai < 2; ++ai)
#pragma unroll
                for (int m = 0; m < 4; ++m) {
                    const int row = row0 + ai * HALF + m * 16; asm volatile("" ::: "memory"); const float rs = row_rs(ssq, row, fq);
                    if (wc == 0 && fq < 2) {
#pragma unroll
                        for (int n = 0; n < 2; ++n) {
                            const int hh = 8 * fq + 4 * n; const f32x4 bb = *(const f32x4*)(bfp + hh); f32x4 o;
#pragma unroll
                            for (int e = 0; e < 4; ++e) { const float x = acc[ai][0][m][n][e] * rs + bb[e]; o[e] = fminf(x, 0.f) - log1pf(__expf(-fabsf(x))); }
                            *(f32x4*)(LFX + (size_t)row * 16 + hh) = o;
                        }
                    }
                }
        }
    }
};
template <class Epi, class Sched, bool ALIGN_EPI = false, bool SP2 = false>
__device__ __forceinline__ void gemm_phase(PG8_LAS unsigned char* lds, const Gemm g, const Sched& S, const Epi& E) {
    int tid_ = threadIdx.x; asm volatile("" : "+v"(tid_)); const int tid = tid_, wid = __builtin_amdgcn_readfirstlane(tid >> 6), lane = tid & 63, wr = wid >> 2, wc = wid & 3, fr = lane & 15, fq = lane >> 4;
    const int K = g.K, nt = K / BK;
    unsigned voffA[2], voffB[2];
#pragma unroll
    for (int i = 0; i < 2; ++i) { int R, C; stage_rc(tid * 16 + i * 8192, R, C); const int Rb = Epi::PERM ? ((R & ~31) + perm32(R & 31)) : R;
        voffA[i] = (unsigned)(R * K + C) * 2u; voffB[i] = (unsigned)(Rb * K + C) * 2u; }
    const size_t kstep = (size_t)(BK * 2);
    const size_t hstep = (size_t)HALF * K * 2;
    const size_t tstep = 2 * hstep;
    const unsigned ldsw = (unsigned)wid * 1024u;
    const int aoff = lds_byte(wr * 64 + fr, fq * 8), boff = lds_byte(wc * 32 + fr, fq * 8);
#define PG8_SA(b, h) (((b) * 2 + (h)) * HTB)
#define PG8_SB(b, h) ((4 + (b) * 2 + (h)) * HTB)
#define PG8_STAGE(bufoff, gbase, voff) do { _Pragma("unroll") for (int _i = 0; _i < 2; ++_i) \
        __builtin_amdgcn_global_load_lds((const unsigned*)((const char*)(gbase) + (voff)[_i]), (PG8_LAS unsigned*)(lds + (bufoff) + ldsw + _i * 8192), 16, 0, 0); } while (0)
#define PG8_LDA(dst, b, h) do { _Pragma("unroll") for (int m = 0; m < 4; ++m) _Pragma("unroll") for (int k = 0; k < 2; ++k) dst[m][k] = *(const PG8_LAS bf16x8*)(lds + PG8_SA(b, h) + aoff + m * 2048 + k * 1024); } while (0)
#define PG8_LDB(dst, b, h) do { _Pragma("unroll") for (int n = 0; n < 2; ++n) _Pragma("unroll") for (int k = 0; k < 2; ++k) dst[n][k] = *(const PG8_LAS bf16x8*)(lds + PG8_SB(b, h) + boff + n * 2048 + k * 1024); } while (0)
#define PG8_MMA(ai, bj, At, Bt) do { __builtin_amdgcn_s_setprio(1); _Pragma("unroll") for (int m = 0; m < 4; ++m) _Pragma("unroll") for (int n = 0; n < 2; ++n) _Pragma("unroll") for (int k = 0; k < 2; ++k) \
        acc[ai][bj][m][n] = __builtin_amdgcn_mfma_f32_16x16x32_bf16(Bt[n][k], At[m][k], acc[ai][bj][m][n], 0, 0, 0); __builtin_amdgcn_s_setprio(0); } while (0)
#define PG8_WAIT_V(n) asm volatile("s_waitcnt vmcnt(" #n ")" ::: "memory")
#define PG8_WAIT_L(n) asm volatile("s_waitcnt lgkmcnt(" #n ")" ::: "memory")
#define PG8_BAR __builtin_amdgcn_s_barrier()
#define PG8_SCHED __builtin_amdgcn_sched_barrier(0)
    Unit cur, nxt; int ui = 0;
    if (!S.next(0, cur)) return;
    f32x4 acc[2][2][4][2];
#pragma unroll
    for (int a = 0; a < 2; ++a)
#pragma unroll
        for (int b = 0; b < 2; ++b)
#pragma unroll
            for (int m = 0; m < 4; ++m)
#pragma unroll
                for (int n = 0; n < 2; ++n) acc[a][b][m][n] = (f32x4){0.f, 0.f, 0.f, 0.f};
    bf16x8 At[4][2], B0[2][2], B1[2][2];
    const char* cA = (const char*)g.A + (size_t)cur.pm * tstep; const char* cB = (const char*)g.Bt + (size_t)cur.pn * tstep;
    S.a_ready(cur);
    if constexpr (SP2) {
        PG8_STAGE(PG8_SB(0, 0), cB, voffB); PG8_STAGE(PG8_SB(0, 1), cB + hstep, voffB); PG8_STAGE(PG8_SA(0, 0), cA, voffA); PG8_STAGE(PG8_SA(0, 1), cA + hstep, voffA);
        if (wr == 1) PG8_BAR;
        PG8_WAIT_V(2); PG8_BAR;
        PG8_STAGE(PG8_SB(1, 0), cB + kstep, voffB); PG8_STAGE(PG8_SA(1, 0), cA + kstep, voffA); PG8_STAGE(PG8_SB(1, 1), cB + hstep + kstep, voffB);
        PG8_WAIT_V(6); PG8_BAR;
    } else {
        PG8_STAGE(PG8_SB(0, 0), cB, voffB); PG8_STAGE(PG8_SA(0, 0), cA, voffA); PG8_STAGE(PG8_SB(0, 1), cB + hstep, voffB); PG8_STAGE(PG8_SA(0, 1), cA + hstep, voffA);
        if (wr == 1) PG8_BAR;
        PG8_WAIT_V(4); PG8_BAR;
        PG8_STAGE(PG8_SB(1, 0), cB + kstep, voffB); PG8_STAGE(PG8_SA(1, 0), cA + kstep, voffA); PG8_STAGE(PG8_SB(1, 1), cB + hstep + kstep, voffB);
        PG8_WAIT_V(6); PG8_BAR;
    }
    for (;;) {
        const bool has_next = S.next(ui + 1, nxt);
        const char* nA = has_next ? (const char*)g.A + (size_t)nxt.pm * tstep : cA; const char* nB = has_next ? (const char*)g.Bt + (size_t)nxt.pn * tstep : cB;
        for (int t = 0; t < nt; t += 2) {
            const bool last = (t == nt - 2);
            const char* a1 = cA + (size_t)(t + 1) * kstep;
            const char* a2 = last ? nA : cA + (size_t)(t + 2) * kstep; const char* b2 = last ? nB : cB + (size_t)(t + 2) * kstep;
            const char* a3 = a2 + kstep; const char* b3 = b2 + kstep;
            if (last && has_next) S.a_ready(nxt);
            if constexpr (SP2) {
            PG8_LDB(B0, 0, 0); PG8_LDB(B1, 0, 1); PG8_SCHED; PG8_LDA(At, 0, 0); PG8_STAGE(PG8_SA(1, 1), a1 + hstep, voffA);
            PG8_WAIT_V(8); PG8_WAIT_L(0); PG8_BAR; PG8_MMA(0, 0, At, B0); PG8_MMA(0, 1, At, B1); PG8_BAR; PG8_SCHED;
            PG8_LDA(At, 0, 1); PG8_STAGE(PG8_SB(0, 0), b2, voffB); PG8_STAGE(PG8_SB(0, 1), b2 + hstep, voffB); PG8_STAGE(PG8_SA(0, 0), a2, voffA);
            PG8_WAIT_V(8); PG8_WAIT_L(0); PG8_BAR; PG8_MMA(1, 0, At, B0); PG8_MMA(1, 1, At, B1); PG8_BAR; PG8_SCHED;
            PG8_LDB(B0, 1, 0); PG8_LDB(B1, 1, 1); PG8_SCHED; PG8_LDA(At, 1, 0); PG8_STAGE(PG8_SA(0, 1), a2 + hstep, voffA);
            PG8_WAIT_V(8); PG8_WAIT_L(0); PG8_BAR; PG8_MMA(0, 0, At, B0); PG8_MMA(0, 1, At, B1); PG8_BAR; PG8_SCHED;
            PG8_LDA(At, 1, 1); PG8_STAGE(PG8_SB(1, 0), b3, voffB); PG8_STAGE(PG8_SB(1, 1), b3 + hstep, voffB); PG8_STAGE(PG8_SA(1, 0), a3, voffA);
            PG8_WAIT_V(8); PG8_WAIT_L(0); PG8_BAR; PG8_MMA(1, 0, At, B0); PG8_MMA(1, 1, At, B1); PG8_BAR; PG8_SCHED;
            } else {
            PG8_LDB(B0, 0, 0); PG8_SCHED; PG8_LDA(At, 0, 0); PG8_STAGE(PG8_SA(1, 1), a1 + hstep, voffA);
            PG8_WAIT_L(8); PG8_BAR; PG8_WAIT_L(0); PG8_MMA(0, 0, At, B0); PG8_BAR; PG8_SCHED;
            PG8_LDB(B1, 0, 1); PG8_STAGE(PG8_SB(0, 0), b2, voffB);
            PG8_BAR; PG8_WAIT_L(0); PG8_MMA(0, 1, At, B1); PG8_BAR;
            PG8_LDA(At, 0, 1); PG8_STAGE(PG8_SA(0, 0), a2, voffA);
            PG8_BAR; PG8_WAIT_L(0); PG8_MMA(1, 0, At, B0); PG8_BAR; PG8_SCHED;
            PG8_STAGE(PG8_SB(0, 1), b2 + hstep, voffB);
            PG8_WAIT_V(6); PG8_BAR; PG8_MMA(1, 1, At, B1); PG8_BAR;
            PG8_LDB(B0, 1, 0); PG8_SCHED; PG8_LDA(At, 1, 0); PG8_STAGE(PG8_SA(0, 1), a2 + hstep, voffA);
            PG8_WAIT_L(8); PG8_BAR; PG8_WAIT_L(0); PG8_MMA(0, 0, At, B0); PG8_BAR; PG8_SCHED;
            PG8_LDB(B1, 1, 1); PG8_STAGE(PG8_SB(1, 0), b3, voffB);
            PG8_BAR; PG8_WAIT_L(0); PG8_MMA(0, 1, At, B1); PG8_BAR;
            PG8_LDA(At, 1, 1); PG8_STAGE(PG8_SA(1, 0), a3, voffA);
            PG8_BAR; PG8_WAIT_L(0); PG8_MMA(1, 0, At, B0); PG8_BAR; PG8_SCHED;
            PG8_STAGE(PG8_SB(1, 1), b3 + hstep, voffB);
            PG8_WAIT_V(6); PG8_BAR; PG8_MMA(1, 1, At, B1); PG8_BAR;
            }
        }
        if constexpr (ALIGN_EPI) { if (wr == 0) PG8_BAR; }
        if constexpr (!Epi::AFTER_DRAIN) { E(acc, cur, wr, wc, fr, fq); S.done(cur); }
        if (!has_next) break;
#pragma unroll
        for (int a = 0; a < 2; ++a)
#pragma unroll
            for (int b = 0; b < 2; ++b)
#pragma unroll
                for (int m = 0; m < 4; ++m)
#pragma unroll
                    for (int n = 0; n < 2; ++n) acc[a][b][m][n] = (f32x4){0.f, 0.f, 0.f, 0.f};
        cur = nxt; cA = nA; cB = nB; ++ui;
        if constexpr (ALIGN_EPI) { if (wr == 1) PG8_BAR; }
    }
    PG8_WAIT_V(0);
    if constexpr (!ALIGN_EPI) { if (wr == 0) PG8_BAR; }
    PG8_BAR;
    if constexpr (Epi::AFTER_DRAIN) { E.fused(acc, cur, wr, wc, fr, fq, lds, wid, lane); S.done(cur); }
#undef PG8_SA
#undef PG8_SB
#undef PG8_STAGE
#undef PG8_LDA
#undef PG8_LDB
#undef PG8_MMA
#undef PG8_WAIT_V
#undef PG8_WAIT_L
#undef PG8_BAR
#undef PG8_SCHED
}
}

using pg8::bf16_t; using pg8::bf16x8; using pg8::f32x4; using pg8::u32x4;
typedef float f32x16 __attribute__((ext_vector_type(16)));
typedef float f32x2v __attribute__((ext_vector_type(2)));
typedef unsigned u32x2 __attribute__((ext_vector_type(2)));

constexpr int D = 1024, SEQ = 16384, M = 32768, DFF = 2816, NFI = 5632, NXI = 4352, NXI_SRC = 4112;
constexpr float LOG2E = 1.4426950408889634f;
constexpr size_t MiB = 1u << 20;
constexpr size_t WS_SSQ = 1 * MiB, WS_LFX = 3 * MiB, WS_CX = 5 * MiB, WS_DV = 7 * MiB, WS_LB = 9 * MiB;
constexpr size_t WS_WFI = 10 * MiB, WS_WFO = 98 * MiB, WS_WHI = 142 * MiB, WS_WHO = 158 * MiB, WS_WXI = 162 * MiB, WS_WXO = 179 * MiB;
constexpr size_t WS_XB = 183 * MiB, WS_R = 247 * MiB;
constexpr size_t R_HID = 0;
constexpr size_t R_Q = 0, R_V = 64 * MiB, R_G = 128 * MiB, R_LF = 192 * MiB, R_U = 320 * MiB;
constexpr size_t RX_Q = 0, RX_K = 64 * MiB, RX_V = 128 * MiB, RX_G = 192 * MiB;
constexpr size_t WS_END = WS_R + 448 * MiB;
static_assert(R_V == 64 * MiB && R_G == 128 * MiB && RX_K == 64 * MiB && RX_V == 128 * MiB && RX_G == 192 * MiB, "epilogues address q|k|v|g by a 64 MiB stride");
constexpr int LDS_BYTES = 135168;
constexpr int N_PHASES = 35;
#ifndef MK_SPLIT
#define MK_SPLIT 0
#endif
#ifndef MK_DIAG
#define MK_DIAG 0
#endif

__device__ __forceinline__ unsigned pk2(float lo, float hi) { return pg8::cvt_pk_bf16(lo, hi); }
__device__ __forceinline__ bf16_t f2bf(float v) { return (bf16_t)(pk2(v, 0.f) & 0xffffu); }
__device__ __forceinline__ float bf2f(bf16_t v) { return __uint_as_float(((unsigned)v) << 16); }
__device__ __forceinline__ float bflo(unsigned w) { return __uint_as_float(w << 16); }
__device__ __forceinline__ float bfhi(unsigned w) { return __uint_as_float(w & 0xffff0000u); }
__device__ __forceinline__ int crow(int r, int hi) { return (r & 3) + 8 * (r >> 2) + 4 * hi; }
#define LDSW() asm volatile("s_waitcnt lgkmcnt(0)" ::: "memory")
#define OPQ_V(x) asm volatile("" : "+v"(x))
#define OPQ_S(x) asm volatile("" : "+s"(x))
#define MFMA32(a, b, c) __builtin_amdgcn_mfma_f32_32x32x16_bf16((a), (b), (c), 0, 0, 0)
#define MFMA16(a, b, c) __builtin_amdgcn_mfma_f32_16x16x32_bf16((a), (b), (c), 0, 0, 0)
__device__ __forceinline__ float wave_sum(float v) {
#pragma unroll
    for (int o = 1; o < 64; o <<= 1) v += __shfl_xor(v, o);
    return v;
}

__device__ __forceinline__ int drow_of(int mode, int c) {
    if (mode == 1) { if (c < DFF) return 256 * (c >> 7) + (c & 127); const int j = c - DFF; return 256 * (j >> 7) + 128 + (j & 127); }
    if (mode == 2) { if (c >= 4096) return c; const int pn = c >> 8, wc = (c & 255) >> 6, d0 = c & 63; return 256 * pn + (d0 < 32 ? 32 * wc : 128 + 32 * wc); }
    return c;
}
__device__ __forceinline__ void transpose_item(const float* W, int K, int Nsrc, int k0, int n0, bf16_t* WT, int drow0, const float* g, float* scr, int lane) {
    const int col = n0 + (lane & 31);
#pragma unroll 8
    for (int i = 0; i < 32; ++i) {
        const int kk = 2 * i + (lane >> 5);
        float v = (col < Nsrc) ? W[(size_t)(k0 + kk) * Nsrc + col] : 0.f;
        if (g) v *= g[k0 + kk];
        scr[kk * 33 + (lane & 31)] = v;
    }
    LDSW();
    const int c = lane & 7;
#pragma unroll
    for (int j = 0; j < 4; ++j) {
        const int n = (lane >> 3) + 8 * j; const float* s = scr + (8 * c) * 33 + n;
        u32x4 o; o.x = pk2(s[0 * 33], s[1 * 33]); o.y = pk2(s[2 * 33], s[3 * 33]); o.z = pk2(s[4 * 33], s[5 * 33]); o.w = pk2(s[6 * 33], s[7 * 33]);
        *(u32x4*)(WT + (size_t)(drow0 + n) * K + k0 + 8 * c) = o;
    }
    LDSW();
}
__device__ __forceinline__ void conv_mats(const float* W, int K, int Nsrc, bf16_t* WT, int Ndst, int nmat, int mode, int gsel, const float* norm_g, float* scr, int gw, int NGW, int lane) {
    const int nb = (Nsrc + 31) / 32, ipm = (K / 64) * nb;
    for (int it = gw; it < nmat * ipm; it += NGW) {
        const int mat = it / ipm, r = it % ipm, kb = r / nb, nbk = r % nb;
        const float* g = nullptr;
        if (gsel == 1) g = norm_g + ((mat >> 1) * 3 + ((mat & 1) ? 2 : 0)) * 1024;
        else if (gsel == 2) g = norm_g + ((2 * mat) * 3 + 1) * 1024;
        else if (gsel == 3) g = norm_g + ((2 * mat + 1) * 3 + 1) * 1024;
        transpose_item(W + (size_t)mat * K * Nsrc, K, Nsrc, 64 * kb, 32 * nbk, WT + (size_t)mat * Ndst * K, drow_of(mode, 32 * nbk), g, scr, lane);
    }
}

constexpr int HG_UNITS = 4096;
__device__ __forceinline__ void hg_pass_a(unsigned char* lds, const float* LF, const bf16_t* V, bf16_t* U, float* DV, int blk, int G) {
    int tid_ = threadIdx.x; OPQ_V(tid_); const int tid = tid_, lane = tid & 63, w = __builtin_amdgcn_readfirstlane(tid >> 6), r32 = lane & 31, hi = lane >> 5;
    float* tot = (float*)lds; unsigned char* KDt = lds + 2048; unsigned char* Vt = KDt + 128 * 144;
    const int I = tid >> 7, k = tid & 127;
    for (int u = blk; u < HG_UNITS; u += G) {
        const int bh = u >> 8, n = u & 255, b = bh >> 3, h = bh & 7, row0 = b * SEQ + n * 64;
        const float* lfp = LF + (size_t)(row0 + 16 * I) * 1024 + h * 128 + k;
        float lf[16], c[16];
#pragma unroll
        for (int j = 0; j < 16; ++j) lf[j] = lfp[(size_t)j * 1024];
        const u32x4* vp = (const u32x4*)(V + (size_t)(row0 + lane) * 1024 + h * 128 + 16 * w); const u32x4 va = vp[0], vb = vp[1];
        float run = 0.f;
#pragma unroll
        for (int j = 0; j < 16; ++j) { run += lf[j]; c[j] = run; }
        tot[I * 128 + k] = run;
        __syncthreads();
        const float t0 = tot[k], t1 = tot[128 + k], t2 = tot[256 + k], t3 = tot[384 + k];
        const float off = (I == 0) ? 0.f : (I == 1) ? t0 : (I == 2) ? (t0 + t1) : (t0 + t1 + t2);
        const float total = (t0 + t1) + (t2 + t3);
        float kd[16];
#pragma unroll
        for (int j = 0; j < 16; ++j) kd[j] = (1.0f - __expf(lf[j])) * __expf(fminf(total - (off + c[j]), 0.f));
        u32x4 w0, w1;
        w0.x = pk2(kd[0], kd[1]); w0.y = pk2(kd[2], kd[3]); w0.z = pk2(kd[4], kd[5]); w0.w = pk2(kd[6], kd[7]);
        w1.x = pk2(kd[8], kd[9]); w1.y = pk2(kd[10], kd[11]); w1.z = pk2(kd[12], kd[13]); w1.w = pk2(kd[14], kd[15]);
        *(u32x4*)(KDt + k * 144 + 32 * I) = w0; *(u32x4*)(KDt + k * 144 + 32 * I + 16) = w1;
#pragma unroll
        for (int e = 0; e < 4; ++e) {
            *(bf16_t*)(Vt + (16 * w + 2 * e) * 144 + 2 * lane) = (bf16_t)(va[e] & 0xffffu); *(bf16_t*)(Vt + (16 * w + 2 * e + 1) * 144 + 2 * lane) = (bf16_t)(va[e] >> 16);
            *(bf16_t*)(Vt + (16 * w + 8 + 2 * e) * 144 + 2 * lane) = (bf16_t)(vb[e] & 0xffffu); *(bf16_t*)(Vt + (16 * w + 8 + 2 * e + 1) * 144 + 2 * lane) = (bf16_t)(vb[e] >> 16);
        }
        if (I == 0) DV[(size_t)u * 128 + k] = __expf(total);
        __syncthreads();
        const int mi = w >> 1;
#pragma unroll
        for (int t2i = 0; t2i < 2; ++t2i) {
            const int ni = (w & 1) * 2 + t2i; f32x16 acc = {};
#pragma unroll
            for (int ks = 0; ks < 4; ++ks) {
                const bf16x8 a = *(const bf16x8*)(Vt + (32 * mi + r32) * 144 + (16 * ks + 8 * hi) * 2);
                const bf16x8 bb = *(const bf16x8*)(KDt + (32 * ni + r32) * 144 + (16 * ks + 8 * hi) * 2);
                acc = MFMA32(a, bb, acc);
            }
            bf16_t* up = U + (size_t)u * 16384 + 32 * ni + r32;
#pragma unroll
            for (int r = 0; r < 16; ++r) up[(32 * mi + crow(r, hi)) * 128] = f2bf(acc[r]);
        }
        __syncthreads();
    }
}
__device__ __forceinline__ void hg_pass_b(bf16_t* U, const float* DV, int blk, int G) {
    int tid_ = threadIdx.x; OPQ_V(tid_); const int gt = blk * 512 + tid_, NT = G * 512;
    for (int p = gt; p < 131072; p += NT) {
        const int bh = p >> 13, e2 = p & 8191, k0 = (e2 & 63) * 2;
        unsigned* up = (unsigned*)U + (size_t)bh * 256 * 8192 + e2;
        const float* dp = DV + (size_t)bh * 256 * 128 + k0;
        float s0 = 0.f, s1 = 0.f;
        for (int n0 = 0; n0 < 256; n0 += 8) {
            unsigned wv[8]; f32x2v dv[8];
#pragma unroll
            for (int i = 0; i < 8; ++i) { wv[i] = up[(size_t)(n0 + i) * 8192]; dv[i] = *(const f32x2v*)(dp + (size_t)(n0 + i) * 128); }
#pragma unroll
            for (int i = 0; i < 8; ++i) { up[(size_t)(n0 + i) * 8192] = pk2(s0, s1); s0 = dv[i].x * s0 + bflo(wv[i]); s1 = dv[i].y * s1 + bfhi(wv[i]); }
        }
    }
}
__device__ __forceinline__ void hg_pass_c(unsigned char* lds, const float* LF, const bf16_t* Q, const bf16_t* V, const bf16_t* Gt, const bf16_t* U, bf16_t* O, const float* ong, int blk, int G) {
    int tid_ = threadIdx.x; OPQ_V(tid_); const int tid = tid_, lane = tid & 63, w = __builtin_amdgcn_readfirstlane(tid >> 6), r32 = lane & 31, hi = lane >> 5;
    float* tot = (float*)lds; unsigned char* Qh = lds + 2048; unsigned char* Qt = Qh + 17408; unsigned char* Kt = Qt + 17408; unsigned char* Vt = Kt + 43520; unsigned char* P = Vt + 18432;
    float* OL = (float*)Kt;
    const int I = tid >> 7, k = tid & 127;
    for (int u = blk; u < HG_UNITS; u += G) {
        const int bh = u >> 8, n = u & 255, b = bh >> 3, h = bh & 7, row0 = b * SEQ + n * 64;
        const float* lfp = LF + (size_t)(row0 + 16 * I) * 1024 + h * 128 + k;
        const bf16_t* qp = Q + (size_t)(row0 + 16 * I) * 1024 + h * 128 + k;
        float lf[16], c[16]; bf16_t qv[16];
#pragma unroll
        for (int j = 0; j < 16; ++j) { lf[j] = lfp[(size_t)j * 1024]; qv[j] = qp[(size_t)j * 1024]; }
        const u32x4* vp = (const u32x4*)(V + (size_t)(row0 + lane) * 1024 + h * 128 + 16 * w); const u32x4 va = vp[0], vb = vp[1];
        float run = 0.f;
#pragma unroll
        for (int j = 0; j < 16; ++j) { run += lf[j]; c[j] = run; }
        tot[I * 128 + k] = run;
        *(u32x4*)(P + (tid >> 3) * 144 + 16 * (tid & 7)) = (u32x4){0u, 0u, 0u, 0u};
        __syncthreads();
        const float t0 = tot[k], t1 = tot[128 + k], t2 = tot[256 + k];
        const float P1 = t0, P2 = t0 + t1, P3 = t0 + t1 + t2;
        const float off = (I == 0) ? 0.f : (I == 1) ? P1 : (I == 2) ? P2 : P3;
#pragma unroll
        for (int j = 0; j < 16; ++j) {
            const int t = 16 * I + j; const float q = bf2f(qv[j]);
            *(bf16_t*)(Qh + t * 272 + 2 * k) = f2bf(q * __expf(off + c[j]));
            *(bf16_t*)(Qt + t * 272 + 2 * k) = f2bf(q * __expf(c[j]));
            const float kk = 1.0f - __expf(lf[j]);
#pragma unroll
            for (int Ip = 0; Ip < 4; ++Ip) {
                if (Ip >= I) {
                    const float rI = (Ip == 0) ? 0.f : (Ip == 1) ? P1 : (Ip == 2) ? P2 : P3;
                    const float ex = (Ip == I) ? -c[j] : fminf((rI - off) - c[j], 0.f);
                    const int pidx = Ip * (Ip + 1) / 2 + I;
                    *(bf16_t*)(Kt + pidx * 4352 + j * 272 + 2 * k) = f2bf(kk * __expf(ex));
                }
            }
        }
#pragma unroll
        for (int e = 0; e < 4; ++e) {
            *(bf16_t*)(Vt + (16 * w + 2 * e) * 144 + 2 * lane) = (bf16_t)(va[e] & 0xffffu); *(bf16_t*)(Vt + (16 * w + 2 * e + 1) * 144 + 2 * lane) = (bf16_t)(va[e] >> 16);
            *(bf16_t*)(Vt + (16 * w + 8 + 2 * e) * 144 + 2 * lane) = (bf16_t)(vb[e] & 0xffffu); *(bf16_t*)(Vt + (16 * w + 8 + 2 * e + 1) * 144 + 2 * lane) = (bf16_t)(vb[e] >> 16);
        }
        __syncthreads();
        for (int p = w; p < 10; p += 8) {
            const int Ip = (p >= 6) ? 3 : (p >= 3) ? 2 : (p >= 1) ? 1 : 0, J = p - Ip * (Ip + 1) / 2;
            const int fr = lane & 15, fq = lane >> 4; f32x4 acc = {0.f, 0.f, 0.f, 0.f};
#pragma unroll
            for (int ks = 0; ks < 4; ++ks) {
                const bf16x8 a = *(const bf16x8*)(Qt + (16 * Ip + fr) * 272 + (32 * ks + 8 * fq) * 2);
                const bf16x8 bb = *(const bf16x8*)(Kt + p * 4352 + fr * 272 + (32 * ks + 8 * fq) * 2);
                acc = MFMA16(a, bb, acc);
            }
#pragma unroll
            for (int i = 0; i < 4; ++i) {
                const int trow = 4 * fq + i; const float val = (J == Ip && fr > trow) ? 0.f : acc[i];
                *(bf16_t*)(P + (16 * Ip + trow) * 144 + (16 * J + fr) * 2) = f2bf(val);
            }
        }
        __syncthreads();
        {
            const int tm = w >> 2, tn = w & 3; f32x16 acc = {};
            const bf16_t* sp = U + (size_t)u * 16384 + (size_t)(32 * tn + r32) * 128 + 8 * hi;
            bf16x8 sf[8];
#pragma unroll
            for (int ks = 0; ks < 8; ++ks) sf[ks] = *(const bf16x8*)(sp + 16 * ks);
#pragma unroll
            for (int ss = 0; ss < 4; ++ss) {
                const bf16x8 a = *(const bf16x8*)(P + (32 * tm + r32) * 144 + (16 * ss + 8 * hi) * 2);
                const bf16x8 bb = *(const bf16x8*)(Vt + (32 * tn + r32) * 144 + (16 * ss + 8 * hi) * 2);
                acc = MFMA32(a, bb, acc);
            }
#pragma unroll
            for (int ks = 0; ks < 8; ++ks) {
                const bf16x8 a = *(const bf16x8*)(Qh + (32 * tm + r32) * 272 + (16 * ks + 8 * hi) * 2);
                acc = MFMA32(a, sf[ks], acc);
            }
#pragma unroll
            for (int r = 0; r < 16; ++r) OL[(32 * tm + crow(r, hi)) * 132 + 32 * tn + r32] = acc[r];
        }
        __syncthreads();
        {
            const int t = tid >> 3, seg = tid & 7; const float* op = OL + t * 132 + 16 * seg;
            f32x4 o4[4]; float ss = 0.f;
#pragma unroll
            for (int i = 0; i < 4; ++i) { o4[i] = *(const f32x4*)(op + 4 * i); ss += pg8::dot4(o4[i]); }
            ss += __shfl_xor(ss, 1); ss += __shfl_xor(ss, 2); ss += __shfl_xor(ss, 4);
            const float sc = __builtin_amdgcn_rsqf(ss * (1.0f / 128.0f) + 1e-6f);
            const size_t goff = (size_t)(row0 + t) * 1024 + h * 128 + 16 * seg;
            const u32x4 g0 = *(const u32x4*)(Gt + goff), g1 = *(const u32x4*)(Gt + goff + 8);
            u32x4 r0, r1;
#pragma unroll
            for (int i = 0; i < 4; ++i) {
                const f32x4 gn = *(const f32x4*)(ong + 16 * seg + 4 * i);
                const unsigned ga = (i < 2) ? g0[2 * i] : g1[2 * (i - 2)], gb = (i < 2) ? g0[2 * i + 1] : g1[2 * (i - 2) + 1];
                const float a0 = o4[i][0] * sc * gn[0] * bflo(ga), a1 = o4[i][1] * sc * gn[1] * bfhi(ga), a2 = o4[i][2] * sc * gn[2] * bflo(gb), a3 = o4[i][3] * sc * gn[3] * bfhi(gb);
                if (i < 2) { r0[2 * i] = pk2(a0, a1); r0[2 * i + 1] = pk2(a2, a3); } else { r1[2 * (i - 2)] = pk2(a0, a1); r1[2 * (i - 2) + 1] = pk2(a2, a3); }
            }
            *(u32x4*)(O + goff) = r0; *(u32x4*)(O + goff + 8) = r1;
        }
        __syncthreads();
    }
}

__device__ __forceinline__ void fox_scan(unsigned char* lds, const float* LFX, float* CX, int blk, int G) {
    float* tots = (float*)lds; int tid_ = threadIdx.x; OPQ_V(tid_); const int tid = tid_;
    for (int s = blk; s < 32; s += G) {
        const int b = s >> 4, h = s & 15, t0 = tid * 32;
        float v[32];
#pragma unroll
        for (int i = 0; i < 32; ++i) v[i] = LFX[(size_t)(b * SEQ + t0 + i) * 16 + h];
        float run = 0.f;
#pragma unroll
        for (int i = 0; i < 32; ++i) { run += v[i]; v[i] = run; }
        tots[tid] = run;
        __syncthreads();
        float off = 0.f;
        for (int i = 0; i < tid; ++i) off += tots[i];
#pragma unroll
        for (int i = 0; i < 32; ++i) CX[(size_t)s * SEQ + t0 + i] = (off + v[i]) * LOG2E;
        __syncthreads();
    }
}
__device__ __forceinline__ void fox_attn_unit(unsigned char* lds, const bf16_t* Qg, const bf16_t* Kg, const bf16_t* Vg, const bf16_t* Gg, bf16_t* Og, const float* CX, int bh, int qb) {
    int tid_ = threadIdx.x; OPQ_V(tid_); const int tid = tid_, lane = tid & 63, w = __builtin_amdgcn_readfirstlane(tid >> 6), r32 = lane & 31, hi = lane >> 5;
    const int b = bh >> 4, h = bh & 15; const size_t rowbase = (size_t)b * SEQ; const int q0 = qb * 256;
    constexpr int BUFB = 9216 + 9216 + 256;
    const int qg = q0 + 32 * w + r32;
    bf16x8 qr[4];
    { const bf16_t* qp = Qg + (rowbase + qg) * 1024 + h * 64 + 8 * hi;
#pragma unroll
      for (int d0 = 0; d0 < 4; ++d0) qr[d0] = *(const bf16x8*)(qp + 16 * d0); }
    const float* cxs = CX + (size_t)bh * SEQ; const float cref = cxs[q0];
    float m = -1e30f, l = 0.f; f32x16 o0 = {}, o1 = {};
    const int NT = 4 * (qb + 1);
    const int kvK = tid >> 3, segK = tid & 7;
    const bf16_t* kgp = Kg + (rowbase + kvK) * 1024 + h * 64 + 8 * segK;
    const bf16_t* vgp = Vg + (rowbase + lane) * 1024 + h * 64 + 8 * w;
    u32x4 kreg, vreg; float creg = 0.f;
    int jt = NT - 1;
    kreg = *(const u32x4*)(kgp + (size_t)jt * 64 * 1024); vreg = *(const u32x4*)(vgp + (size_t)jt * 64 * 1024); if (tid < 64) creg = cref - cxs[jt * 64 + tid];
    int cur = 0;
    {
        unsigned char* B = lds; *(u32x4*)(B + kvK * 144 + 16 * segK) = kreg;
#pragma unroll
        for (int e = 0; e < 4; ++e) { *(bf16_t*)(B + 9216 + (8 * w + 2 * e) * 144 + 2 * lane) = (bf16_t)(vreg[e] & 0xffffu); *(bf16_t*)(B + 9216 + (8 * w + 2 * e + 1) * 144 + 2 * lane) = (bf16_t)(vreg[e] >> 16); }
        if (tid < 64) *(float*)(B + 18432 + 4 * tid) = creg;
    }
    __syncthreads();
    for (; jt >= 0; --jt) {
        const bool has_next = jt > 0;
        if (has_next) { kreg = *(const u32x4*)(kgp + (size_t)(jt - 1) * 64 * 1024); vreg = *(const u32x4*)(vgp + (size_t)(jt - 1) * 64 * 1024); if (tid < 64) creg = cref - cxs[(jt - 1) * 64 + tid]; }
        const unsigned char* B = lds + cur * BUFB; const int kv0 = jt * 64;
        if (kv0 <= q0 + 32 * w + 31) {
            f32x16 p0, p1;
            const float* ck = (const float*)(B + 18432);
#pragma unroll
            for (int g = 0; g < 4; ++g) {
                const f32x4 c0 = *(const f32x4*)(ck + 8 * g + 4 * hi), c1 = *(const f32x4*)(ck + 32 + 8 * g + 4 * hi);
                p0[4 * g] = c0[0]; p0[4 * g + 1] = c0[1]; p0[4 * g + 2] = c0[2]; p0[4 * g + 3] = c0[3];
                p1[4 * g] = c1[0]; p1[4 * g + 1] = c1[1]; p1[4 * g + 2] = c1[2]; p1[4 * g + 3] = c1[3];
            }
#pragma unroll
            for (int d0 = 0; d0 < 4; ++d0) {
                const bf16x8 k0f = *(const bf16x8*)(B + r32 * 144 + 32 * d0 + 16 * hi), k1f = *(const bf16x8*)(B + (32 + r32) * 144 + 32 * d0 + 16 * hi);
                p0 = MFMA32(k0f, qr[d0], p0); p1 = MFMA32(k1f, qr[d0], p1);
            }
            if (kv0 + 63 > q0 + 32 * w) {
#pragma unroll
                for (int r = 0; r < 16; ++r) { const int kv = kv0 + crow(r, hi); if (kv > qg) p0[r] = -INFINITY; if (kv + 32 > qg) p1[r] = -INFINITY; }
            }
            float mx = fmaxf(p0[0], p1[0]);
#pragma unroll
            for (int r = 1; r < 16; ++r) mx = fmaxf(mx, fmaxf(p0[r], p1[r]));
            mx = fmaxf(mx, __shfl_xor(mx, 32));
            const float mnew = fmaxf(m, mx), alpha = __builtin_amdgcn_exp2f(m - mnew); m = mnew;
            float ls = 0.f;
#pragma unroll
            for (int r = 0; r < 16; ++r) { p0[r] = __builtin_amdgcn_exp2f(p0[r] - mnew); p1[r] = __builtin_amdgcn_exp2f(p1[r] - mnew); ls += p0[r] + p1[r]; }
            l = l * alpha + ls;
#pragma unroll
            for (int r = 0; r < 16; ++r) { o0[r] *= alpha; o1[r] *= alpha; }
            const unsigned char* Vt = B + 9216;
#pragma unroll
            for (int j2 = 0; j2 < 4; ++j2) {
                const int rr = (j2 & 1) * 8; u32x4 pw;
                if (j2 < 2) { pw.x = pk2(p0[rr], p0[rr + 1]); pw.y = pk2(p0[rr + 2], p0[rr + 3]); pw.z = pk2(p0[rr + 4], p0[rr + 5]); pw.w = pk2(p0[rr + 6], p0[rr + 7]); }
                else { pw.x = pk2(p1[rr], p1[rr + 1]); pw.y = pk2(p1[rr + 2], p1[rr + 3]); pw.z = pk2(p1[rr + 4], p1[rr + 5]); pw.w = pk2(p1[rr + 6], p1[rr + 7]); }
                const bf16x8 pf = __builtin_bit_cast(bf16x8, pw);
                const int kvb = 32 * (j2 >> 1) + 16 * (j2 & 1) + 4 * hi;
#pragma unroll
                for (int dh = 0; dh < 2; ++dh) {
                    const unsigned char* vrow = Vt + (32 * dh + r32) * 144 + 2 * kvb;
                    const u32x2 lo = *(const u32x2*)(vrow), hh = *(const u32x2*)(vrow + 16);
                    const u32x4 vw = {lo.x, lo.y, hh.x, hh.y}; const bf16x8 vf = __builtin_bit_cast(bf16x8, vw);
                    if (dh == 0) o0 = MFMA32(vf, pf, o0); else o1 = MFMA32(vf, pf, o1);
                }
            }
        }
        if (has_next) {
            unsigned char* Bn = lds + (cur ^ 1) * BUFB; *(u32x4*)(Bn + kvK * 144 + 16 * segK) = kreg;
#pragma unroll
            for (int e = 0; e < 4; ++e) { *(bf16_t*)(Bn + 9216 + (8 * w + 2 * e) * 144 + 2 * lane) = (bf16_t)(vreg[e] & 0xffffu); *(bf16_t*)(Bn + 9216 + (8 * w + 2 * e + 1) * 144 + 2 * lane) = (bf16_t)(vreg[e] >> 16); }
            if (tid < 64) *(float*)(Bn + 18432 + 4 * tid) = creg;
        }
        __syncthreads();
        cur ^= 1;
    }
    l += __shfl_xor(l, 32);
    const float inv = 1.0f / l;
    const size_t ooff = (rowbase + qg) * 1024 + h * 64 + 4 * hi;
#pragma unroll
    for (int dh = 0; dh < 2; ++dh)
#pragma unroll
        for (int g = 0; g < 4; ++g) {
            const size_t off = ooff + 32 * dh + 8 * g; const u32x2 gg = *(const u32x2*)(Gg + off);
            float a0, a1, a2, a3;
            if (dh == 0) { a0 = o0[4 * g]; a1 = o0[4 * g + 1]; a2 = o0[4 * g + 2]; a3 = o0[4 * g + 3]; } else { a0 = o1[4 * g]; a1 = o1[4 * g + 1]; a2 = o1[4 * g + 2]; a3 = o1[4 * g + 3]; }
            u32x2 ov; ov.x = pk2(a0 * inv * bflo(gg.x), a1 * inv * bfhi(gg.x)); ov.y = pk2(a2 * inv * bflo(gg.y), a3 * inv * bfhi(gg.y));
            *(u32x2*)(Og + off) = ov;
        }
}
__device__ __forceinline__ void fox_attn(unsigned char* lds, const bf16_t* Qg, const bf16_t* Kg, const bf16_t* Vg, const bf16_t* Gg, bf16_t* Og, const float* CX, int blk, int G) {
    for (int i = blk; i < 2048; i += G) {
        const int j = i >> 8, vcu = i & 255, bh = vcu >> 3, s = vcu & 7, qb = (j & 1) ? 8 * j + 7 - s : 8 * j + s;
        fox_attn_unit(lds, Qg, Kg, Vg, Gg, Og, CX, bh, qb);
    }
}

struct Args { const float* in[13]; float* out; unsigned char* ws; int ph_lo, ph_hi; };
#define PHASE_PTRS() size_t zoff_ = 0; OPQ_S(zoff_); unsigned char* ws = a.ws + zoff_; float* out = a.out + zoff_; \
    float* SSQ = (float*)(ws + WS_SSQ); bf16_t* XB = (bf16_t*)(ws + WS_XB); unsigned char* R = ws + WS_R; (void)SSQ; (void)XB; (void)R; (void)out
#define RUN_PH() (ph >= a.ph_lo && ph < a.ph_hi)
#define SEAM() do { if (ph >= a.ph_lo && ph + 1 < a.ph_hi) { asm volatile("s_waitcnt vmcnt(0)" ::: "memory"); __builtin_amdgcn_fence(__ATOMIC_RELEASE, "agent"); grid.sync(); __builtin_amdgcn_fence(__ATOMIC_ACQUIRE, "agent"); } ++ph; } while (0)
__global__ void __launch_bounds__(512, 2) mega_fwd(Args a) {
    extern __shared__ __attribute__((aligned(16))) unsigned char lds[];
    cg::grid_group grid = cg::this_grid();
    const int blk = blockIdx.x, G = gridDim.x; int ph = 0;
    __attribute__((address_space(3))) unsigned char* glds = (__attribute__((address_space(3))) unsigned char*)lds;

    if (RUN_PH()) {
        PHASE_PTRS();
        int tid = threadIdx.x; OPQ_V(tid); const int lane = tid & 63, wave = __builtin_amdgcn_readfirstlane(tid >> 6);
        const float* x = a.in[0]; const float* norm_g = a.in[1];
        float* scr = (float*)(lds + wave * 16384);
        const int gw = blk * 8 + wave, NGW = G * 8;
        conv_mats(a.in[2], D, NFI, (bf16_t*)(ws + WS_WFI), NFI, 8, 1, 1, norm_g, scr, gw, NGW, lane);
        conv_mats(a.in[3], DFF, D, (bf16_t*)(ws + WS_WFO), D, 8, 0, 0, norm_g, scr, gw, NGW, lane);
        conv_mats(a.in[4], D, 4096, (bf16_t*)(ws + WS_WHI), 4096, 2, 0, 2, norm_g, scr, gw, NGW, lane);
        conv_mats(a.in[7], D, D, (bf16_t*)(ws + WS_WHO), D, 2, 0, 0, norm_g, scr, gw, NGW, lane);
        conv_mats(a.in[8], D, NXI_SRC, (bf16_t*)(ws + WS_WXI), NXI, 2, 2, 3, norm_g, scr, gw, NGW, lane);
        conv_mats(a.in[12], D, D, (bf16_t*)(ws + WS_WXO), D, 2, 0, 0, norm_g, scr, gw, NGW, lane);
        { bf16_t* WXI = (bf16_t*)(ws + WS_WXI);
          for (int i = blk * 512 + tid; i < 2 * 224 * 128; i += G * 512) { const int mat = i / (224 * 128), r = i % (224 * 128); *(u32x4*)(WXI + (size_t)mat * NXI * D + (size_t)4128 * D + (size_t)r * 8) = (u32x4){0u, 0u, 0u, 0u}; } }
        for (int mrow = gw; mrow < M; mrow += NGW) {
            const f32x4* xr = (const f32x4*)(x + (size_t)mrow * D) + lane; f32x4 v[4]; float s = 0.f;
#pragma unroll
            for (int j = 0; j < 4; ++j) { v[j] = xr[64 * j]; s += pg8::dot4(v[j]); }
            s = wave_sum(s);
            u32x2* o8 = (u32x2*)(XB + (size_t)mrow * D) + lane;
#pragma unroll
            for (int j = 0; j < 4; ++j) { u32x2 p; p.x = pk2(v[j][0], v[j][1]); p.y = pk2(v[j][2], v[j][3]); o8[64 * j] = p; }
            if (lane < 16) SSQ[(size_t)mrow * 16 + lane] = (lane == 0) ? s : 0.f;
        }
        { const float* lg = a.in[5]; float* LB = (float*)(ws + WS_LB);
          for (int i = blk * 512 + tid; i < 1024; i += G * 512) { const float l0 = lg[i], l1 = lg[1024 + i]; LB[i] = 0.f; LB[1024 + i] = 1.0f / (1.0f + __expf(l0 - l1)); } }
    }
    SEAM();

    for (int L = 0; L < 4; ++L) {
        const int j = L >> 1;
        for (int s = 0; s < 2; ++s) {
            if (RUN_PH()) {
                PHASE_PTRS();
                pg8::Gemm g{XB, (bf16_t*)(ws + WS_WFI) + (size_t)(2 * L + s) * NFI * D, M, NFI, D}; pg8::StaticOrder S; S.init(M, NFI, G, blk);
                pg8::EpiSwiglu E{(bf16_t*)(R + R_HID), SSQ, DFF};
#ifndef NO_G1
                pg8::gemm_phase<pg8::EpiSwiglu, pg8::StaticOrder, true, true>(glds, g, S, E);
#endif
            }
            SEAM();
            if (RUN_PH()) {
                PHASE_PTRS();
                pg8::Gemm g{(bf16_t*)(R + R_HID), (bf16_t*)(ws + WS_WFO) + (size_t)(2 * L + s) * D * DFF, M, D, DFF}; pg8::StaticOrder S; S.init(M, D, G, blk);
                const float* base = (L == 0 && s == 0) ? a.in[0] : out;
                pg8::EpiResid E{base, out, XB, SSQ, 0.5f};
#ifndef NO_G2
                pg8::gemm_phase<pg8::EpiResid, pg8::StaticOrder, true, true>(glds, g, S, E);
#endif
            }
            SEAM();
            if (s == 0) {
                if ((L & 1) == 0) {
                    if (RUN_PH()) {
                        PHASE_PTRS();
                        pg8::Gemm g{XB, (bf16_t*)(ws + WS_WHI) + (size_t)j * 4096 * D, M, 4096, D}; pg8::StaticOrder S; S.init(M, 4096, G, blk);
                        pg8::EpiHgrn E{(bf16_t*)(R + R_Q), (float*)(R + R_LF), (const float*)(ws + WS_LB) + j * 1024, SSQ};
#ifndef NO_G3
                        pg8::gemm_phase<pg8::EpiHgrn, pg8::StaticOrder, true, true>(glds, g, S, E);
#endif
                    }
                    SEAM();
#ifndef NO_HA
                    if (RUN_PH()) { PHASE_PTRS(); hg_pass_a(lds, (const float*)(R + R_LF), (const bf16_t*)(R + R_V), (bf16_t*)(R + R_U), (float*)(ws + WS_DV), blk, G); }
#endif
                    SEAM();
#ifndef NO_HB
                    if (RUN_PH()) { PHASE_PTRS(); hg_pass_b((bf16_t*)(R + R_U), (const float*)(ws + WS_DV), blk, G); }
#endif
                    SEAM();
#ifndef NO_HC
                    if (RUN_PH()) { PHASE_PTRS(); hg_pass_c(lds, (const float*)(R + R_LF), (const bf16_t*)(R + R_Q), (const bf16_t*)(R + R_V), (const bf16_t*)(R + R_G), (const bf16_t*)(R + R_U), (bf16_t*)(R + R_Q), a.in[6] + j * 128, blk, G); }
#endif
                    SEAM();
                } else {
                    if (RUN_PH()) {
                        PHASE_PTRS();
                        pg8::Gemm g{XB, (bf16_t*)(ws + WS_WXI) + (size_t)j * NXI * D, M, NXI, D}; pg8::StaticOrder S; S.init(M, NXI, G, blk);
                        pg8::EpiFox E{(bf16_t*)(R + RX_Q), (float*)(ws + WS_LFX), a.in[10] + j * 64, a.in[11] + j * 64, a.in[9] + j * 16, SSQ};
#ifndef NO_G5
                        pg8::gemm_phase<pg8::EpiFox, pg8::StaticOrder, true, true>(glds, g, S, E);
#endif
                    }
                    SEAM();
#ifndef NO_FS
                    if (RUN_PH()) { PHASE_PTRS(); fox_scan(lds, (const float*)(ws + WS_LFX), (float*)(ws + WS_CX), blk, G); }
#endif
                    SEAM();
#ifndef NO_FA
                    if (RUN_PH()) { PHASE_PTRS(); fox_attn(lds, (const bf16_t*)(R + RX_Q), (const bf16_t*)(R + RX_K), (const bf16_t*)(R + RX_V), (const bf16_t*)(R + RX_G), (bf16_t*)(R + RX_Q), (const float*)(ws + WS_CX), blk, G); }
#endif
                    SEAM();
                }
                if (RUN_PH()) {
                    PHASE_PTRS();
                    const bf16_t* Wt = ((L & 1) == 0) ? ((bf16_t*)(ws + WS_WHO) + (size_t)j * D * D) : ((bf16_t*)(ws + WS_WXO) + (size_t)j * D * D);
                    pg8::Gemm g{(bf16_t*)(R + R_Q), Wt, M, D, D}; pg8::StaticOrder S; S.init(M, D, G, blk);
                    pg8::EpiResid E{out, out, XB, SSQ, 1.0f};
#ifndef NO_G2
                    pg8::gemm_phase<pg8::EpiResid, pg8::StaticOrder, true, true>(glds, g, S, E);
#endif
                }
                SEAM();
            }
        }
    }
}


#if MK_DIAG == 1
__global__ void diag_bits(float* out, int n) { for (int i = blockIdx.x * blockDim.x + threadIdx.x; i < n; i += gridDim.x * blockDim.x) { const unsigned b = __float_as_uint(out[i]); const bool bad = ((b >> 23) & 0xffu) == 0xffu; out[i] = bad ? 77.0f : (float)(b & 0xffffu) * (1.0f / 65536.0f); } }
#endif

#if MK_DIAG == 2
__global__ void diag_scan(const unsigned* p, size_t nwords, int is_bf16, unsigned* flag, unsigned bit) {
    bool bad = false;
    for (size_t i = (size_t)blockIdx.x * blockDim.x + threadIdx.x; i < nwords; i += (size_t)gridDim.x * blockDim.x) {
        const unsigned w = p[i];
        if (is_bf16) bad |= ((w & 0x7f80u) == 0x7f80u) || ((w & 0x7f800000u) == 0x7f800000u); else bad |= ((w & 0x7f800000u) == 0x7f800000u);
    }
    if (bad) atomicOr(flag, bit);
}
__global__ void diag_emit(float* out, int n, const unsigned* flag) { const float v = 1000.0f * (10.0f + (float)flag[0]); for (int i = blockIdx.x * blockDim.x + threadIdx.x; i < n; i += gridDim.x * blockDim.x) out[i] = (i == 0) ? v : 0.f; }
#endif
extern "C" void kernel_launch(void* const* d_in, const int* in_sizes, int n_in, void* d_out, int out_size, void* d_ws, size_t ws_size, hipStream_t stream) {
    static int grid = 0;
    if (grid == 0) {
        if (n_in != 13 || out_size != M * D || ws_size < WS_END) { fprintf(stderr, "kernel_launch: unexpected problem (n_in %d out %d ws %zu)\n", n_in, out_size, ws_size); grid = -1; return; }
        int dev = 0, cus = 0, per_cu = 0;
        hipGetDevice(&dev); hipDeviceGetAttribute(&cus, hipDeviceAttributeMultiprocessorCount, dev);
        hipFuncSetAttribute((const void*)mega_fwd, hipFuncAttributeMaxDynamicSharedMemorySize, LDS_BYTES);
        hipOccupancyMaxActiveBlocksPerMultiprocessor(&per_cu, (const void*)mega_fwd, 512, LDS_BYTES);
        if (per_cu < 1) { fprintf(stderr, "kernel_launch: occupancy query says %d blocks per CU\n", per_cu); per_cu = 1; }
        grid = cus * 1;
        (void)hipGetLastError();
    }
    if (grid < 0) return;
    Args a{};
    for (int i = 0; i < 13; ++i) a.in[i] = (const float*)d_in[i];
    a.out = (float*)d_out; a.ws = (unsigned char*)d_ws;
    hipError_t e = hipSuccess;
#if MK_SPLIT
#ifndef MK_STOP
#define MK_STOP N_PHASES
#endif
#if MK_DIAG == 2
    hipMemsetAsync(d_ws, 0, 256, stream);
#endif
    for (int p = 0; p < MK_STOP && e == hipSuccess; ++p) { a.ph_lo = p; a.ph_hi = p + 1; hipLaunchKernelGGL(mega_fwd, dim3(grid), dim3(512), LDS_BYTES, stream, a); e = hipPeekAtLastError(); }
#else
    a.ph_lo = 0; a.ph_hi = N_PHASES;
    void* args[] = {&a};
    e = hipLaunchCooperativeKernel((const void*)mega_fwd, dim3(grid), dim3(512), args, LDS_BYTES, stream);
#endif
#if MK_DIAG == 2
    { unsigned char* w8 = (unsigned char*)d_ws; unsigned* flag = (unsigned*)w8;
      const size_t regs[6][3] = MK_REGIONS;
      for (int r = 0; r < 6; ++r) { if (regs[r][1] == 0) continue; const unsigned* p = (regs[r][0] == ~(size_t)0) ? (const unsigned*)d_out : (const unsigned*)(w8 + regs[r][0]);
        hipLaunchKernelGGL(diag_scan, dim3(2048), dim3(256), 0, stream, p, regs[r][1] / 4, (int)regs[r][2], flag, 1u << r); }
      hipLaunchKernelGGL(diag_emit, dim3(2048), dim3(256), 0, stream, (float*)d_out, out_size, (const unsigned*)flag); }
#endif
#if MK_DIAG == 1
    hipLaunchKernelGGL(diag_bits, dim3(2048), dim3(256), 0, stream, (float*)d_out, out_size);
#endif
    if (e != hipSuccess) fprintf(stderr, "kernel_launch: cooperative launch failed: %s (grid %d)\n", hipGetErrorString(e), grid);
}
```

```cpp
#include <hip/hip_runtime.h>
#include <hip/hip_cooperative_groups.h>
#include <cstdio>
#include <cstdint>
namespace cg = cooperative_groups;
namespace pg8 {
#define PG8_LAS __attribute__((address_space(3)))
typedef unsigned short bf16_t;
typedef short bf16x8 __attribute__((ext_vector_type(8)));
typedef float f32x4 __attribute__((ext_vector_type(4)));
typedef unsigned u32x4 __attribute__((ext_vector_type(4)));
constexpr int BM = 256, BK = 64, HALF = 128, HTB = HALF * BK * 2  , STAGE_BYTES = 8 * HTB, NXCD = 8, WGM = 8;

__host__ __device__ __forceinline__ int lds_byte(int r, int c) { const int st = (r >> 4) * 2 + (c >> 5), rr = r & 15, cc = c & 31, ob = rr * 64 + cc * 2; return st * 1024 + (ob ^ (((ob >> 9) & 1) << 5)); }
__host__ __device__ __forceinline__ void stage_rc(int b, int& R, int& C) { const int st = b / 1024, sb = b % 1024, swz = sb ^ (((sb >> 9) & 1) << 5); R = (st >> 1) * 16 + swz / 64; C = (st & 1) * 32 + (swz % 64) / 2; }
__host__ __device__ __forceinline__ int perm32(int rho) { const int n = rho >> 4, i = rho & 15; return 8 * (i >> 2) + 4 * n + (i & 3); }

struct Unit { int pm, pn; };
struct Gemm { const bf16_t* A; const bf16_t* Bt; int M, N, K; };

struct StaticOrder {
    int nM, nN, nwg, G, c;
    __host__ __device__ void init(int M, int N, int G_, int c_) { nM = M / BM; nN = N / BM; nwg = nM * nN; G = G_; c = c_; }
    __host__ __device__ bool next(int i, Unit& u) const {
        const long L = (long)i * G + c; if (L >= nwg) return false;
        int wgid = (int)L; { const int q = nwg / NXCD, r = nwg % NXCD, xcd = wgid % NXCD, off = wgid / NXCD; wgid = (xcd < r ? xcd * (q + 1) : r * (q + 1) + (xcd - r) * q) + off; }
        const int nig = WGM * nN, gid = wgid / nig, fm = gid * WGM, gsz = (nM - fm) < WGM ? (nM - fm) : WGM;
        u.pm = fm + ((wgid % nig) % gsz); u.pn = (wgid % nig) / gsz; return true;
    }
    __device__ __forceinline__ void a_ready(const Unit&) const {}
    __device__ __forceinline__ void done(const Unit&) const {}
};

typedef float f32x2_cvt __attribute__((ext_vector_type(2))); typedef __bf16 bf16x2_cvt __attribute__((ext_vector_type(2)));
__device__ __forceinline__ unsigned cvt_pk_bf16(float lo, float hi) { const f32x2_cvt v = {lo, hi}; const bf16x2_cvt b = __builtin_convertvector(v, bf16x2_cvt); return __builtin_bit_cast(unsigned, b); }
typedef float f32x2 __attribute__((ext_vector_type(2)));
typedef float f32x2 __attribute__((ext_vector_type(2)));
constexpr float RMS_EPS = 1e-6f;
constexpr size_t BUF_STRIDE = (size_t)32 << 20;
constexpr float LOG2E = 1.4426950408889634f;
constexpr float FOX_C2 = 0.125f * 1.4426950408889634f;
__device__ __forceinline__ float fast_sigmoid(float x) { return __builtin_amdgcn_rcpf(1.0f + __builtin_amdgcn_exp2f(-x * LOG2E)); }
__device__ __forceinline__ float fast_silu(float x) { return x * fast_sigmoid(x); }
__device__ __forceinline__ f32x4 silu4(f32x4 v) { return (f32x4){fast_silu(v[0]), fast_silu(v[1]), fast_silu(v[2]), fast_silu(v[3])}; }
__device__ __forceinline__ f32x4 sigm4(f32x4 v) { return (f32x4){fast_sigmoid(v[0]), fast_sigmoid(v[1]), fast_sigmoid(v[2]), fast_sigmoid(v[3])}; }
__device__ __forceinline__ u32x4 pack8(f32x4 a, f32x4 b) { u32x4 w; w.x = cvt_pk_bf16(a[0], a[1]); w.y = cvt_pk_bf16(a[2], a[3]); w.z = cvt_pk_bf16(b[0], b[1]); w.w = cvt_pk_bf16(b[2], b[3]); return w; }
__device__ __forceinline__ float dot4(f32x4 a) { return (a[0] * a[0] + a[1] * a[1]) + (a[2] * a[2] + a[3] * a[3]); }
__device__ __forceinline__ float row_rs(const float* ssq, int row, int fq) {
    const f32x4 v = *(const f32x4*)(ssq + (size_t)row * 16 + 4 * fq);
    float s = (v[0] + v[1]) + (v[2] + v[3]);
    s += __shfl_xor(s, 16); s += __shfl_xor(s, 32);
    return __builtin_amdgcn_rsqf(s * (1.0f / 1024.0f) + RMS_EPS);
}
struct EpiSwiglu {
    static constexpr bool PERM = true, AFTER_DRAIN = false;
    bf16_t* H; const float* ssq; int ldh;
    __device__ __forceinline__ void operator()(const f32x4 (&acc)[2][2][4][2], const Unit& u, int wr, int wc, int fr_in, int fq_in) const {
        int fr = fr_in, fq = fq_in; asm volatile("" : "+v"(fr), "+v"(fq));
        const int row0 = u.pm * BM + wr * 64 + fr, col0 = u.pn * 128 + wc * 32 + 8 * fq;
#pragma unroll
        for (int ai = 0; ai < 2; ++ai)
#pragma unroll
            for (int m = 0; m < 4; ++m) {
                const int row = row0 + ai * HALF + m * 16; asm volatile("" ::: "memory"); const float rs = row_rs(ssq, row, fq);
                const f32x4 g0 = acc[ai][0][m][0] * rs, g1 = acc[ai][0][m][1] * rs, u0 = acc[ai][1][m][0] * rs, u1 = acc[ai][1][m][1] * rs;
                const f32x4 h0 = silu4(g0) * u0, h1 = silu4(g1) * u1;
                *(u32x4*)(H + (size_t)row * ldh + col0) = pack8(h0, h1);
            }
    }
};
struct EpiResid {
    static constexpr bool PERM = true, AFTER_DRAIN = false;
    const float* base; float* out; bf16_t* xb; float* ssq; float scale;
    __device__ __forceinline__ void operator()(const f32x4 (&acc)[2][2][4][2], const Unit& u, int wr, int wc, int fr_in, int fq_in) const {
        int fr = fr_in, fq = fq_in; asm volatile("" : "+v"(fr), "+v"(fq));
        const int row0 = u.pm * BM + wr * 64 + fr, col0 = u.pn * BM + wc * 32 + 8 * fq;
#pragma unroll
        for (int ai = 0; ai < 2; ++ai)
#pragma unroll
            for (int m = 0; m < 4; ++m) {
                asm volatile("" ::: "memory"); const int row = row0 + ai * HALF + m * 16; float ss = 0.f;
#pragma unroll
                for (int bj = 0; bj < 2; ++bj) {
                    const size_t off = (size_t)row * 1024 + col0 + bj * HALF;
                    const f32x4 b0 = *(const f32x4*)(base + off), b1 = *(const f32x4*)(base + off + 4);
                    const f32x4 o0 = b0 + acc[ai][bj][m][0] * scale, o1 = b1 + acc[ai][bj][m][1] * scale;
                    *(f32x4*)(out + off) = o0; *(f32x4*)(out + off + 4) = o1;
                    *(u32x4*)(xb + off) = pack8(o0, o1);
                    ss += dot4(o0) + dot4(o1);
                }
                ss += __shfl_xor(ss, 16); ss += __shfl_xor(ss, 32);
                if (fq == 0) ssq[(size_t)row * 16 + u.pn * 4 + wc] = ss;
            }
    }
};
__device__ __forceinline__ float logf1(float z, float a) { const float f = a + (1.0f - a) * fast_sigmoid(z); return __logf(fmaxf(f, 1e-30f)); }
__device__ __forceinline__ f32x4 logf4(f32x4 z, f32x4 a) { return (f32x4){logf1(z[0], a[0]), logf1(z[1], a[1]), logf1(z[2], a[2]), logf1(z[3], a[3])}; }
struct EpiHgrn {
    static constexpr bool PERM = true, AFTER_DRAIN = false;
    bf16_t* Q; float* LF; const float* lb; const float* ssq;
    __device__ __forceinline__ void operator()(const f32x4 (&acc)[2][2][4][2], const Unit& u, int wr, int wc, int fr_in, int fq_in) const {
        int fr = fr_in, fq = fq_in; asm volatile("" : "+v"(fr), "+v"(fq));
        const int sec = u.pn >> 2; const int row0 = u.pm * BM + wr * 64 + fr, cl0 = (u.pn & 3) * BM + wc * 32 + 8 * fq;
#pragma unroll
        for (int ai = 0; ai < 2; ++ai)
#pragma unroll
            for (int m = 0; m < 4; ++m) {
                const int row = row0 + ai * HALF + m * 16; asm volatile("" ::: "memory"); const float rs = row_rs(ssq, row, fq);
#pragma unroll
                for (int bj = 0; bj < 2; ++bj) {
                    f32x4 v0 = acc[ai][bj][m][0] * rs, v1 = acc[ai][bj][m][1] * rs; const size_t off = (size_t)row * 1024 + cl0 + bj * HALF;
                    if (sec == 1) {
                        const f32x4 la0 = *(const f32x4*)(lb + cl0 + bj * HALF), la1 = *(const f32x4*)(lb + cl0 + bj * HALF + 4);
                        const f32x4 l0 = logf4(v0, la0), l1 = logf4(v1, la1);
                        *(f32x4*)(LF + off) = l0; *(f32x4*)(LF + off + 4) = l1;
                    } else {
                        if (sec != 2) { v0 = silu4(v0); v1 = silu4(v1); }
                        bf16_t* dst = Q + (size_t)((sec == 0) ? 0 : (sec == 2) ? 1 : 2) * BUF_STRIDE;
                        *(u32x4*)(dst + off) = pack8(v0, v1);
                    }
                }
            }
    }
};
struct EpiFox {
    static constexpr bool PERM = true, AFTER_DRAIN = false;
    bf16_t* Q; float* LFX; const float *gq, *gk, *bfp; const float* ssq;
    __device__ __forceinline__ void operator()(const f32x4 (&acc)[2][2][4][2], const Unit& u, int wr, int wc, int fr_in, int fq_in) const {
        int fr = fr_in, fq = fq_in; asm volatile("" : "+v"(fr), "+v"(fq));
        const int row0 = u.pm * BM + wr * 64 + fr;
        if (u.pn < 16) {
            const int sec = u.pn >> 2; const int colh = (u.pn & 3) * BM + wc * 64 + 8 * fq;
            f32x4 gv[2][2];
#pragma unroll
            for (int bj = 0; bj < 2; ++bj)
#pragma unroll
                for (int n = 0; n < 2; ++n) {
                    const int d = 32 * bj + 8 * fq + 4 * n;
                    gv[bj][n] = (sec == 0) ? *(const f32x4*)(gq + d) * FOX_C2 : (sec == 1) ? *(const f32x4*)(gk + d) : (f32x4){1.f, 1.f, 1.f, 1.f};
                }
            bf16_t* dst = Q + (size_t)sec * BUF_STRIDE;
#pragma unroll
            for (int ai = 0; ai < 2; ++ai)
#pragma unroll
                for (int m = 0; m < 4; ++m) {
                    const int row = row0 + ai * HALF + m * 16; asm volatile("" ::: "memory"); const float rs = row_rs(ssq, row, fq);
                    f32x4 v[2][2]; float ss = 0.f;
#pragma unroll
                    for (int bj = 0; bj < 2; ++bj)
#pragma unroll
                        for (int n = 0; n < 2; ++n) { v[bj][n] = acc[ai][bj][m][n] * rs; ss += dot4(v[bj][n]); }
                    if (sec < 2) {
                        ss += __shfl_xor(ss, 16); ss += __shfl_xor(ss, 32);
                        const float sc = __builtin_amdgcn_rsqf(ss * (1.0f / 64.0f) + RMS_EPS);
#pragma unroll
                        for (int bj = 0; bj < 2; ++bj)
#pragma unroll
                            for (int n = 0; n < 2; ++n) v[bj][n] = v[bj][n] * sc * gv[bj][n];
                    } else if (sec == 3) {
#pragma unroll
                        for (int bj = 0; bj < 2; ++bj)
#pragma unroll
                            for (int n = 0; n < 2; ++n) v[bj][n] = sigm4(v[bj][n]);
                    }
#pragma unroll
                    for (int bj = 0; bj < 2; ++bj) *(u32x4*)(dst + (size_t)row * 1024 + colh + 32 * bj) = pack8(v[bj][0], v[bj][1]);
                }
        } else {
#pragma unroll
            for (int ai = 0; ai < 2; ++ai)
#pragma unroll
                for (int m = 0; m < 4; ++m) {
                    const int row = row0 + ai * HALF + m * 16; asm volatile("" ::: "memory"); const float rs = row_rs(ssq, row, fq);
                    if (wc == 0 && fq < 2) {
#pragma unroll
                        for (int n = 0; n < 2; ++n) {
                            const int hh = 8 * fq + 4 * n; const f32x4 bb = *(const f32x4*)(bfp + hh); f32x4 o;
#pragma unroll
                            for (int e = 0; e < 4; ++e) { const float x = acc[ai][0][m][n][e] * rs + bb[e]; o[e] = fminf(x, 0.f) - log1pf(__expf(-fabsf(x))); }
                            *(f32x4*)(LFX + (size_t)row * 16 + hh) = o;
                        }
                    }
                }
        }
    }
};
template <class Epi, class Sched, bool ALIGN_EPI = false, bool SP2 = false>
__device__ __forceinline__ void gemm_phase(PG8_LAS unsigned char* lds, const Gemm g, const Sched& S, const Epi& E) {
    int tid_ = threadIdx.x; asm volatile("" : "+v"(tid_)); const int tid = tid_, wid = __builtin_amdgcn_readfirstlane(tid >> 6), lane = tid & 63, wr = wid >> 2, wc = wid & 3, fr = lane & 15, fq = lane >> 4;
    const int K = g.K, nt = K / BK;
    unsigned voffA[2], voffB[2];
#pragma unroll
    for (int i = 0; i < 2; ++i) { int R, C; stage_rc(tid * 16 + i * 8192, R, C); const int Rb = Epi::PERM ? ((R & ~31) + perm32(R & 31)) : R;
        voffA[i] = (unsigned)(R * K + C) * 2u; voffB[i] = (unsigned)(Rb * K + C) * 2u; }
    const size_t kstep = (size_t)(BK * 2);
    const size_t hstep = (size_t)HALF * K * 2;
    const size_t tstep = 2 * hstep;
    const unsigned ldsw = (unsigned)wid * 1024u;
    const int aoff = lds_byte(wr * 64 + fr, fq * 8), boff = lds_byte(wc * 32 + fr, fq * 8);
#define PG8_SA(b, h) (((b) * 2 + (h)) * HTB)
#define PG8_SB(b, h) ((4 + (b) * 2 + (h)) * HTB)
#define PG8_STAGE(bufoff, gbase, voff) do { _Pragma("unroll") for (int _i = 0; _i < 2; ++_i) \
        __builtin_amdgcn_global_load_lds((const unsigned*)((const char*)(gbase) + (voff)[_i]), (PG8_LAS unsigned*)(lds + (bufoff) + ldsw + _i * 8192), 16, 0, 0); } while (0)
#define PG8_LDA(dst, b, h) do { _Pragma("unroll") for (int m = 0; m < 4; ++m) _Pragma("unroll") for (int k = 0; k < 2; ++k) dst[m][k] = *(const PG8_LAS bf16x8*)(lds + PG8_SA(b, h) + aoff + m * 2048 + k * 1024); } while (0)
#define PG8_LDB(dst, b, h) do { _Pragma("unroll") for (int n = 0; n < 2; ++n) _Pragma("unroll") for (int k = 0; k < 2; ++k) dst[n][k] = *(const PG8_LAS bf16x8*)(lds + PG8_SB(b, h) + boff + n * 2048 + k * 1024); } while (0)
#define PG8_MMA(ai, bj, At, Bt) do { __builtin_amdgcn_s_setprio(1); _Pragma("unroll") for (int m = 0; m < 4; ++m) _Pragma("unroll") for (int n = 0; n < 2; ++n) _Pragma("unroll") for (int k = 0; k < 2; ++k) \
        acc[ai][bj][m][n] = __builtin_amdgcn_mfma_f32_16x16x32_bf16(Bt[n][k], At[m][k], acc[ai][bj][m][n], 0, 0, 0); __builtin_amdgcn_s_setprio(0); } while (0)
#define PG8_WAIT_V(n) asm volatile("s_waitcnt vmcnt(" #n ")" ::: "memory")
#define PG8_WAIT_L(n) asm volatile("s_waitcnt lgkmcnt(" #n ")" ::: "memory")
#define PG8_BAR __builtin_amdgcn_s_barrier()
#define PG8_SCHED __builtin_amdgcn_sched_barrier(0)
    Unit cur, nxt; int ui = 0;
    if (!S.next(0, cur)) return;
    f32x4 acc[2][2][4][2];
#pragma unroll
    for (int a = 0; a < 2; ++a)
#pragma unroll
        for (int b = 0; b < 2; ++b)
#pragma unroll
            for (int m = 0; m < 4; ++m)
#pragma unroll
                for (int n = 0; n < 2; ++n) acc[a][b][m][n] = (f32x4){0.f, 0.f, 0.f, 0.f};
    bf16x8 At[4][2], B0[2][2], B1[2][2];
    const char* cA = (const char*)g.A + (size_t)cur.pm * tstep; const char* cB = (const char*)g.Bt + (size_t)cur.pn * tstep;
    S.a_ready(cur);
    if constexpr (SP2) {
        PG8_STAGE(PG8_SB(0, 0), cB, voffB); PG8_STAGE(PG8_SB(0, 1), cB + hstep, voffB); PG8_STAGE(PG8_SA(0, 0), cA, voffA); PG8_STAGE(PG8_SA(0, 1), cA + hstep, voffA);
        if (wr == 1) PG8_BAR;
        PG8_WAIT_V(2); PG8_BAR;
        PG8_STAGE(PG8_SB(1, 0), cB + kstep, voffB); PG8_STAGE(PG8_SA(1, 0), cA + kstep, voffA); PG8_STAGE(PG8_SB(1, 1), cB + hstep + kstep, voffB);
        PG8_WAIT_V(6); PG8_BAR;
    } else {
        PG8_STAGE(PG8_SB(0, 0), cB, voffB); PG8_STAGE(PG8_SA(0, 0), cA, voffA); PG8_STAGE(PG8_SB(0, 1), cB + hstep, voffB); PG8_STAGE(PG8_SA(0, 1), cA + hstep, voffA);
        if (wr == 1) PG8_BAR;
        PG8_WAIT_V(4); PG8_BAR;
        PG8_STAGE(PG8_SB(1, 0), cB + kstep, voffB); PG8_STAGE(PG8_SA(1, 0), cA + kstep, voffA); PG8_STAGE(PG8_SB(1, 1), cB + hstep + kstep, voffB);
        PG8_WAIT_V(6); PG8_BAR;
    }
    for (;;) {
        const bool has_next = S.next(ui + 1, nxt);
        const char* nA = has_next ? (const char*)g.A + (size_t)nxt.pm * tstep : cA; const char* nB = has_next ? (const char*)g.Bt + (size_t)nxt.pn * tstep : cB;
        for (int t = 0; t < nt; t += 2) {
            const bool last = (t == nt - 2);
            const char* a1 = cA + (size_t)(t + 1) * kstep;
            const char* a2 = last ? nA : cA + (size_t)(t + 2) * kstep; const char* b2 = last ? nB : cB + (size_t)(t + 2) * kstep;
            const char* a3 = a2 + kstep; const char* b3 = b2 + kstep;
            if (last && has_next) S.a_ready(nxt);
            if constexpr (SP2) {
            PG8_LDB(B0, 0, 0); PG8_LDB(B1, 0, 1); PG8_SCHED; PG8_LDA(At, 0, 0); PG8_STAGE(PG8_SA(1, 1), a1 + hstep, voffA);
            PG8_WAIT_V(8); PG8_WAIT_L(0); PG8_BAR; PG8_MMA(0, 0, At, B0); PG8_MMA(0, 1, At, B1); PG8_BAR; PG8_SCHED;
            PG8_LDA(At, 0, 1); PG8_STAGE(PG8_SB(0, 0), b2, voffB); PG8_STAGE(PG8_SB(0, 1), b2 + hstep, voffB); PG8_STAGE(PG8_SA(0, 0), a2, voffA);
            PG8_WAIT_V(8); PG8_WAIT_L(0); PG8_BAR; PG8_MMA(1, 0, At, B0); PG8_MMA(1, 1, At, B1); PG8_BAR; PG8_SCHED;
            PG8_LDB(B0, 1, 0); PG8_LDB(B1, 1, 1); PG8_SCHED; PG8_LDA(At, 1, 0); PG8_STAGE(PG8_SA(0, 1), a2 + hstep, voffA);
            PG8_WAIT_V(8); PG8_WAIT_L(0); PG8_BAR; PG8_MMA(0, 0, At, B0); PG8_MMA(0, 1, At, B1); PG8_BAR; PG8_SCHED;
            PG8_LDA(At, 1, 1); PG8_STAGE(PG8_SB(1, 0), b3, voffB); PG8_STAGE(PG8_SB(1, 1), b3 + hstep, voffB); PG8_STAGE(PG8_SA(1, 0), a3, voffA);
            PG8_WAIT_V(8); PG8_WAIT_L(0); PG8_BAR; PG8_MMA(1, 0, At, B0); PG8_MMA(1, 1, At, B1); PG8_BAR; PG8_SCHED;
            } else {
            PG8_LDB(B0, 0, 0); PG8_SCHED; PG8_LDA(At, 0, 0); PG8_STAGE(PG8_SA(1, 1), a1 + hstep, voffA);
            PG8_WAIT_L(8); PG8_BAR; PG8_WAIT_L(0); PG8_MMA(0, 0, At, B0); PG8_BAR; PG8_SCHED;
            PG8_LDB(B1, 0, 1); PG8_STAGE(PG8_SB(0, 0), b2, voffB);
            PG8_BAR; PG8_WAIT_L(0); PG8_MMA(0, 1, At, B1); PG8_BAR;
            PG8_LDA(At, 0, 1); PG8_STAGE(PG8_SA(0, 0), a2, voffA);
            PG8_BAR; PG8_WAIT_L(0); PG8_MMA(1, 0, At, B0); PG8_BAR; PG8_SCHED;
            PG8_STAGE(PG8_SB(0, 1), b2 + hstep, voffB);
            PG8_WAIT_V(6); PG8_BAR; PG8_MMA(1, 1, At, B1); PG8_BAR;
            PG8_LDB(B0, 1, 0); PG8_SCHED; PG8_LDA(At, 1, 0); PG8_STAGE(PG8_SA(0, 1), a2 + hstep, voffA);
            PG8_WAIT_L(8); PG8_BAR; PG8_WAIT_L(0); PG8_MMA(0, 0, At, B0); PG8_BAR; PG8_SCHED;
            PG8_LDB(B1, 1, 1); PG8_STAGE(PG8_SB(1, 0), b3, voffB);
            PG8_BAR; PG8_WAIT_L(0); PG8_MMA(0, 1, At, B1); PG8_BAR;
            PG8_LDA(At, 1, 1); PG8_STAGE(PG8_SA(1, 0), a3, voffA);
            PG8_BAR; PG8_WAIT_L(0); PG8_MMA(1, 0, At, B0); PG8_BAR; PG8_SCHED;
            PG8_STAGE(PG8_SB(1, 1), b3 + hstep, voffB);
            PG8_WAIT_V(6); PG8_BAR; PG8_MMA(1, 1, At, B1); PG8_BAR;
            }
        }
        if constexpr (ALIGN_EPI) { if (wr == 0) PG8_BAR; }
        if constexpr (!Epi::AFTER_DRAIN) { E(acc, cur, wr, wc, fr, fq); S.done(cur); }
        if (!has_next) break;
#pragma unroll
        for (int a = 0; a < 2; ++a)
#pragma unroll
            for (int b = 0; b < 2; ++b)
#pragma unroll
                for (int m = 0; m < 4; ++m)
#pragma unroll
                    for (int n = 0; n < 2; ++n) acc[a][b][m][n] = (f32x4){0.f, 0.f, 0.f, 0.f};
        cur = nxt; cA = nA; cB = nB; ++ui;
        if constexpr (ALIGN_EPI) { if (wr == 1) PG8_BAR; }
    }
    PG8_WAIT_V(0);
    if constexpr (!ALIGN_EPI) { if (wr == 0) PG8_BAR; }
    PG8_BAR;
    if constexpr (Epi::AFTER_DRAIN) { E.fused(acc, cur, wr, wc, fr, fq, lds, wid, lane); S.done(cur); }
#undef PG8_SA
#undef PG8_SB
#undef PG8_STAGE
#undef PG8_LDA
#undef PG8_LDB
#undef PG8_MMA
#undef PG8_WAIT_V
#undef PG8_WAIT_L
#undef PG8_BAR
#undef PG8_SCHED
}
}

using pg8::bf16_t; using pg8::bf16x8; using pg8::f32x4; using pg8::u32x4;
typedef float f32x16 __attribute__((ext_vector_type(16)));
typedef float f32x2v __attribute__((ext_vector_type(2)));
typedef unsigned u32x2 __attribute__((ext_vector_type(2)));

constexpr int D = 1024, SEQ = 16384, M = 32768, DFF = 2816, NFI = 5632, NXI = 4352, NXI_SRC = 4112;
constexpr float LOG2E = 1.4426950408889634f;
constexpr size_t MiB = 1u << 20;
constexpr size_t WS_SSQ = 1 * MiB, WS_LFX = 3 * MiB, WS_CX = 5 * MiB, WS_DV = 7 * MiB, WS_LB = 9 * MiB;
constexpr size_t WS_WFI = 10 * MiB, WS_WFO = 98 * MiB, WS_WHI = 142 * MiB, WS_WHO = 158 * MiB, WS_WXI = 162 * MiB, WS_WXO = 179 * MiB;
constexpr size_t WS_XB = 183 * MiB, WS_R = 247 * MiB;
constexpr size_t R_HID = 0;
constexpr size_t R_Q = 0, R_V = 64 * MiB, R_G = 128 * MiB, R_LF = 192 * MiB, R_U = 320 * MiB;
constexpr size_t RX_Q = 0, RX_K = 64 * MiB, RX_V = 128 * MiB, RX_G = 192 * MiB;
constexpr size_t WS_END = WS_R + 448 * MiB;
static_assert(R_V == 64 * MiB && R_G == 128 * MiB && RX_K == 64 * MiB && RX_V == 128 * MiB && RX_G == 192 * MiB, "epilogues address q|k|v|g by a 64 MiB stride");
constexpr int LDS_BYTES = 135168;
constexpr int N_PHASES = 35;
#ifndef MK_SPLIT
#define MK_SPLIT 0
#endif
#ifndef MK_DIAG
#define MK_DIAG 0
#endif

__device__ __forceinline__ unsigned pk2(float lo, float hi) { return pg8::cvt_pk_bf16(lo, hi); }
__device__ __forceinline__ bf16_t f2bf(float v) { return (bf16_t)(pk2(v, 0.f) & 0xffffu); }
__device__ __forceinline__ float bf2f(bf16_t v) { return __uint_as_float(((unsigned)v) << 16); }
__device__ __forceinline__ float bflo(unsigned w) { return __uint_as_float(w << 16); }
__device__ __forceinline__ float bfhi(unsigned w) { return __uint_as_float(w & 0xffff0000u); }
__device__ __forceinline__ int crow(int r, int hi) { return (r & 3) + 8 * (r >> 2) + 4 * hi; }
#define LDSW() asm volatile("s_waitcnt lgkmcnt(0)" ::: "memory")
#define OPQ_V(x) asm volatile("" : "+v"(x))
#define OPQ_S(x) asm volatile("" : "+s"(x))
#define MFMA32(a, b, c) __builtin_amdgcn_mfma_f32_32x32x16_bf16((a), (b), (c), 0, 0, 0)
#define MFMA16(a, b, c) __builtin_amdgcn_mfma_f32_16x16x32_bf16((a), (b), (c), 0, 0, 0)
__device__ __forceinline__ float wave_sum(float v) {
#pragma unroll
    for (int o = 1; o < 64; o <<= 1) v += __shfl_xor(v, o);
    return v;
}

__device__ __forceinline__ int drow_of(int mode, int c) {
    if (mode == 1) { if (c < DFF) return 256 * (c >> 7) + (c & 127); const int j = c - DFF; return 256 * (j >> 7) + 128 + (j & 127); }
    if (mode == 2) { if (c >= 4096) return c; const int pn = c >> 8, wc = (c & 255) >> 6, d0 = c & 63; return 256 * pn + (d0 < 32 ? 32 * wc : 128 + 32 * wc); }
    return c;
}
__device__ __forceinline__ void transpose_item(const float* W, int K, int Nsrc, int k0, int n0, bf16_t* WT, int drow0, const float* g, float* scr, int lane) {
    const int col = n0 + (lane & 31);
#pragma unroll 8
    for (int i = 0; i < 32; ++i) {
        const int kk = 2 * i + (lane >> 5);
        float v = (col < Nsrc) ? W[(size_t)(k0 + kk) * Nsrc + col] : 0.f;
        if (g) v *= g[k0 + kk];
        scr[kk * 33 + (lane & 31)] = v;
    }
    LDSW();
    const int c = lane & 7;
#pragma unroll
    for (int j = 0; j < 4; ++j) {
        const int n = (lane >> 3) + 8 * j; const float* s = scr + (8 * c) * 33 + n;
        u32x4 o; o.x = pk2(s[0 * 33], s[1 * 33]); o.y = pk2(s[2 * 33], s[3 * 33]); o.z = pk2(s[4 * 33], s[5 * 33]); o.w = pk2(s[6 * 33], s[7 * 33]);
        *(u32x4*)(WT + (size_t)(drow0 + n) * K + k0 + 8 * c) = o;
    }
    LDSW();
}
__device__ __forceinline__ void conv_mats(const float* W, int K, int Nsrc, bf16_t* WT, int Ndst, int nmat, int mode, int gsel, const float* norm_g, float* scr, int gw, int NGW, int lane) {
    const int nb = (Nsrc + 31) / 32, ipm = (K / 64) * nb;
    for (int it = gw; it < nmat * ipm; it += NGW) {
        const int mat = it / ipm, r = it % ipm, kb = r / nb, nbk = r % nb;
        const float* g = nullptr;
        if (gsel == 1) g = norm_g + ((mat >> 1) * 3 + ((mat & 1) ? 2 : 0)) * 1024;
        else if (gsel == 2) g = norm_g + ((2 * mat) * 3 + 1) * 1024;
        else if (gsel == 3) g = norm_g + ((2 * mat + 1) * 3 + 1) * 1024;
        transpose_item(W + (size_t)mat * K * Nsrc, K, Nsrc, 64 * kb, 32 * nbk, WT + (size_t)mat * Ndst * K, drow_of(mode, 32 * nbk), g, scr, lane);
    }
}

constexpr int HG_UNITS = 4096;
__device__ __forceinline__ void hg_pass_a(unsigned char* lds, const float* LF, const bf16_t* V, bf16_t* U, float* DV, int blk, int G) {
    int tid_ = threadIdx.x; OPQ_V(tid_); const int tid = tid_, lane = tid & 63, w = __builtin_amdgcn_readfirstlane(tid >> 6), r32 = lane & 31, hi = lane >> 5;
    float* tot = (float*)lds; unsigned char* KDt = lds + 2048; unsigned char* Vt = KDt + 128 * 144;
    const int I = tid >> 7, k = tid & 127;
    for (int u = blk; u < HG_UNITS; u += G) {
        const int bh = u >> 8, n = u & 255, b = bh >> 3, h = bh & 7, row0 = b * SEQ + n * 64;
        const float* lfp = LF + (size_t)(row0 + 16 * I) * 1024 + h * 128 + k;
        float lf[16], c[16];
#pragma unroll
        for (int j = 0; j < 16; ++j) lf[j] = lfp[(size_t)j * 1024];
        const u32x4* vp = (const u32x4*)(V + (size_t)(row0 + lane) * 1024 + h * 128 + 16 * w); const u32x4 va = vp[0], vb = vp[1];
        float run = 0.f;
#pragma unroll
        for (int j = 0; j < 16; ++j) { run += lf[j]; c[j] = run; }
        tot[I * 128 + k] = run;
        __syncthreads();
        const float t0 = tot[k], t1 = tot[128 + k], t2 = tot[256 + k], t3 = tot[384 + k];
        const float off = (I == 0) ? 0.f : (I == 1) ? t0 : (I == 2) ? (t0 + t1) : (t0 + t1 + t2);
        const float total = (t0 + t1) + (t2 + t3);
        float kd[16];
#pragma unroll
        for (int j = 0; j < 16; ++j) kd[j] = (1.0f - __expf(lf[j])) * __expf(fminf(total - (off + c[j]), 0.f));
        u32x4 w0, w1;
        w0.x = pk2(kd[0], kd[1]); w0.y = pk2(kd[2], kd[3]); w0.z = pk2(kd[4], kd[5]); w0.w = pk2(kd[6], kd[7]);
        w1.x = pk2(kd[8], kd[9]); w1.y = pk2(kd[10], kd[11]); w1.z = pk2(kd[12], kd[13]); w1.w = pk2(kd[14], kd[15]);
        *(u32x4*)(KDt + k * 144 + 32 * I) = w0; *(u32x4*)(KDt + k * 144 + 32 * I + 16) = w1;
#pragma unroll
        for (int e = 0; e < 4; ++e) {
            *(bf16_t*)(Vt + (16 * w + 2 * e) * 144 + 2 * lane) = (bf16_t)(va[e] & 0xffffu); *(bf16_t*)(Vt + (16 * w + 2 * e + 1) * 144 + 2 * lane) = (bf16_t)(va[e] >> 16);
            *(bf16_t*)(Vt + (16 * w + 8 + 2 * e) * 144 + 2 * lane) = (bf16_t)(vb[e] & 0xffffu); *(bf16_t*)(Vt + (16 * w + 8 + 2 * e + 1) * 144 + 2 * lane) = (bf16_t)(vb[e] >> 16);
        }
        if (I == 0) DV[(size_t)u * 128 + k] = __expf(total);
        __syncthreads();
        const int mi = w >> 1;
#pragma unroll
        for (int t2i = 0; t2i < 2; ++t2i) {
            const int ni = (w & 1) * 2 + t2i; f32x16 acc = {};
#pragma unroll
            for (int ks = 0; ks < 4; ++ks) {
                const bf16x8 a = *(const bf16x8*)(Vt + (32 * mi + r32) * 144 + (16 * ks + 8 * hi) * 2);
                const bf16x8 bb = *(const bf16x8*)(KDt + (32 * ni + r32) * 144 + (16 * ks + 8 * hi) * 2);
                acc = MFMA32(a, bb, acc);
            }
            bf16_t* up = U + (size_t)u * 16384 + 32 * ni + r32;
#pragma unroll
            for (int r = 0; r < 16; ++r) up[(32 * mi + crow(r, hi)) * 128] = f2bf(acc[r]);
        }
        __syncthreads();
    }
}
__device__ __forceinline__ void hg_pass_b(bf16_t* U, const float* DV, int blk, int G) {
    int tid_ = threadIdx.x; OPQ_V(tid_); const int gt = blk * 512 + tid_, NT = G * 512;
    for (int p = gt; p < 131072; p += NT) {
        const int bh = p >> 13, e2 = p & 8191, k0 = (e2 & 63) * 2;
        unsigned* up = (unsigned*)U + (size_t)bh * 256 * 8192 + e2;
        const float* dp = DV + (size_t)bh * 256 * 128 + k0;
        float s0 = 0.f, s1 = 0.f;
        for (int n0 = 0; n0 < 256; n0 += 8) {
            unsigned wv[8]; f32x2v dv[8];
#pragma unroll
            for (int i = 0; i < 8; ++i) { wv[i] = up[(size_t)(n0 + i) * 8192]; dv[i] = *(const f32x2v*)(dp + (size_t)(n0 + i) * 128); }
#pragma unroll
            for (int i = 0; i < 8; ++i) { up[(size_t)(n0 + i) * 8192] = pk2(s0, s1); s0 = dv[i].x * s0 + bflo(wv[i]); s1 = dv[i].y * s1 + bfhi(wv[i]); }
        }
    }
}
__device__ __forceinline__ void hg_pass_c(unsigned char* lds, const float* LF, const bf16_t* Q, const bf16_t* V, const bf16_t* Gt, const bf16_t* U, bf16_t* O, const float* ong, int blk, int G) {
    int tid_ = threadIdx.x; OPQ_V(tid_); const int tid = tid_, lane = tid & 63, w = __builtin_amdgcn_readfirstlane(tid >> 6), r32 = lane & 31, hi = lane >> 5;
    float* tot = (float*)lds; unsigned char* Qh = lds + 2048; unsigned char* Qt = Qh + 17408; unsigned char* Kt = Qt + 17408; unsigned char* Vt = Kt + 43520; unsigned char* P = Vt + 18432;
    float* OL = (float*)Kt;
    const int I = tid >> 7, k = tid & 127;
    for (int u = blk; u < HG_UNITS; u += G) {
        const int bh = u >> 8, n = u & 255, b = bh >> 3, h = bh & 7, row0 = b * SEQ + n * 64;
        const float* lfp = LF + (size_t)(row0 + 16 * I) * 1024 + h * 128 + k;
        const bf16_t* qp = Q + (size_t)(row0 + 16 * I) * 1024 + h * 128 + k;
        float lf[16], c[16]; bf16_t qv[16];
#pragma unroll
        for (int j = 0; j < 16; ++j) { lf[j] = lfp[(size_t)j * 1024]; qv[j] = qp[(size_t)j * 1024]; }
        const u32x4* vp = (const u32x4*)(V + (size_t)(row0 + lane) * 1024 + h * 128 + 16 * w); const u32x4 va = vp[0], vb = vp[1];
        float run = 0.f;
#pragma unroll
        for (int j = 0; j < 16; ++j) { run += lf[j]; c[j] = run; }
        tot[I * 128 + k] = run;
        *(u32x4*)(P + (tid >> 3) * 144 + 16 * (tid & 7)) = (u32x4){0u, 0u, 0u, 0u};
        __syncthreads();
        const float t0 = tot[k], t1 = tot[128 + k], t2 = tot[256 + k];
        const float P1 = t0, P2 = t0 + t1, P3 = t0 + t1 + t2;
        const float off = (I == 0) ? 0.f : (I == 1) ? P1 : (I == 2) ? P2 : P3;
#pragma unroll
        for (int j = 0; j < 16; ++j) {
            const int t = 16 * I + j; const float q = bf2f(qv[j]);
            *(bf16_t*)(Qh + t * 272 + 2 * k) = f2bf(q * __expf(off + c[j]));
            *(bf16_t*)(Qt + t * 272 + 2 * k) = f2bf(q * __expf(c[j]));
            const float kk = 1.0f - __expf(lf[j]);
#pragma unroll
            for (int Ip = 0; Ip < 4; ++Ip) {
                if (Ip >= I) {
                    const float rI = (Ip == 0) ? 0.f : (Ip == 1) ? P1 : (Ip == 2) ? P2 : P3;
                    const float ex = (Ip == I) ? -c[j] : fminf((rI - off) - c[j], 0.f);
                    const int pidx = Ip * (Ip + 1) / 2 + I;
                    *(bf16_t*)(Kt + pidx * 4352 + j * 272 + 2 * k) = f2bf(kk * __expf(ex));
                }
            }
        }
#pragma unroll
        for (int e = 0; e < 4; ++e) {
            *(bf16_t*)(Vt + (16 * w + 2 * e) * 144 + 2 * lane) = (bf16_t)(va[e] & 0xffffu); *(bf16_t*)(Vt + (16 * w + 2 * e + 1) * 144 + 2 * lane) = (bf16_t)(va[e] >> 16);
            *(bf16_t*)(Vt + (16 * w + 8 + 2 * e) * 144 + 2 * lane) = (bf16_t)(vb[e] & 0xffffu); *(bf16_t*)(Vt + (16 * w + 8 + 2 * e + 1) * 144 + 2 * lane) = (bf16_t)(vb[e] >> 16);
        }
        __syncthreads();
        for (int p = w; p < 10; p += 8) {
            const int Ip = (p >= 6) ? 3 : (p >= 3) ? 2 : (p >= 1) ? 1 : 0, J = p - Ip * (Ip + 1) / 2;
            const int fr = lane & 15, fq = lane >> 4; f32x4 acc = {0.f, 0.f, 0.f, 0.f};
#pragma unroll
            for (int ks = 0; ks < 4; ++ks) {
                const bf16x8 a = *(const bf16x8*)(Qt + (16 * Ip + fr) * 272 + (32 * ks + 8 * fq) * 2);
                const bf16x8 bb = *(const bf16x8*)(Kt + p * 4352 + fr * 272 + (32 * ks + 8 * fq) * 2);
                acc = MFMA16(a, bb, acc);
            }
#pragma unroll
            for (int i = 0; i < 4; ++i) {
                const int trow = 4 * fq + i; const float val = (J == Ip && fr > trow) ? 0.f : acc[i];
                *(bf16_t*)(P + (16 * Ip + trow) * 144 + (16 * J + fr) * 2) = f2bf(val);
            }
        }
        __syncthreads();
        {
            const int tm = w >> 2, tn = w & 3; f32x16 acc = {};
            const bf16_t* sp = U + (size_t)u * 16384 + (size_t)(32 * tn + r32) * 128 + 8 * hi;
            bf16x8 sf[8];
#pragma unroll
            for (int ks = 0; ks < 8; ++ks) sf[ks] = *(const bf16x8*)(sp + 16 * ks);
#pragma unroll
            for (int ss = 0; ss < 4; ++ss) {
                const bf16x8 a = *(const bf16x8*)(P + (32 * tm + r32) * 144 + (16 * ss + 8 * hi) * 2);
                const bf16x8 bb = *(const bf16x8*)(Vt + (32 * tn + r32) * 144 + (16 * ss + 8 * hi) * 2);
                acc = MFMA32(a, bb, acc);
            }
#pragma unroll
            for (int ks = 0; ks < 8; ++ks) {
                const bf16x8 a = *(const bf16x8*)(Qh + (32 * tm + r32) * 272 + (16 * ks + 8 * hi) * 2);
                acc = MFMA32(a, sf[ks], acc);
            }
#pragma unroll
            for (int r = 0; r < 16; ++r) OL[(32 * tm + crow(r, hi)) * 132 + 32 * tn + r32] = acc[r];
        }
        __syncthreads();
        {
            const int t = tid >> 3, seg = tid & 7; const float* op = OL + t * 132 + 16 * seg;
            f32x4 o4[4]; float ss = 0.f;
#pragma unroll
            for (int i = 0; i < 4; ++i) { o4[i] = *(const f32x4*)(op + 4 * i); ss += pg8::dot4(o4[i]); }
            ss += __shfl_xor(ss, 1); ss += __shfl_xor(ss, 2); ss += __shfl_xor(ss, 4);
            const float sc = __builtin_amdgcn_rsqf(ss * (1.0f / 128.0f) + 1e-6f);
            const size_t goff = (size_t)(row0 + t) * 1024 + h * 128 + 16 * seg;
            const u32x4 g0 = *(const u32x4*)(Gt + goff), g1 = *(const u32x4*)(Gt + goff + 8);
            u32x4 r0, r1;
#pragma unroll
            for (int i = 0; i < 4; ++i) {
                const f32x4 gn = *(const f32x4*)(ong + 16 * seg + 4 * i);
                const unsigned ga = (i < 2) ? g0[2 * i] : g1[2 * (i - 2)], gb = (i < 2) ? g0[2 * i + 1] : g1[2 * (i - 2) + 1];
                const float a0 = o4[i][0] * sc * gn[0] * bflo(ga), a1 = o4[i][1] * sc * gn[1] * bfhi(ga), a2 = o4[i][2] * sc * gn[2] * bflo(gb), a3 = o4[i][3] * sc * gn[3] * bfhi(gb);
                if (i < 2) { r0[2 * i] = pk2(a0, a1); r0[2 * i + 1] = pk2(a2, a3); } else { r1[2 * (i - 2)] = pk2(a0, a1); r1[2 * (i - 2) + 1] = pk2(a2, a3); }
            }
            *(u32x4*)(O + goff) = r0; *(u32x4*)(O + goff + 8) = r1;
        }
        __syncthreads();
    }
}

__device__ __forceinline__ void fox_scan(unsigned char* lds, const float* LFX, float* CX, int blk, int G) {
    float* tots = (float*)lds; int tid_ = threadIdx.x; OPQ_V(tid_); const int tid = tid_;
    for (int s = blk; s < 32; s += G) {
        const int b = s >> 4, h = s & 15, t0 = tid * 32;
        float v[32];
#pragma unroll
        for (int i = 0; i < 32; ++i) v[i] = LFX[(size_t)(b * SEQ + t0 + i) * 16 + h];
        float run = 0.f;
#pragma unroll
        for (int i = 0; i < 32; ++i) { run += v[i]; v[i] = run; }
        tots[tid] = run;
        __syncthreads();
        float off = 0.f;
        for (int i = 0; i < tid; ++i) off += tots[i];
#pragma unroll
        for (int i = 0; i < 32; ++i) CX[(size_t)s * SEQ + t0 + i] = (off + v[i]) * LOG2E;
        __syncthreads();
    }
}
__device__ __forceinline__ void fox_attn_unit(unsigned char* lds, const bf16_t* Qg, const bf16_t* Kg, const bf16_t* Vg, const bf16_t* Gg, bf16_t* Og, const float* CX, int bh, int qb, float qkb) {
    int tid_ = threadIdx.x; OPQ_V(tid_); const int tid = tid_, lane = tid & 63, w = __builtin_amdgcn_readfirstlane(tid >> 6), r32 = lane & 31, hi = lane >> 5;
    const int b = bh >> 4, h = bh & 15; const size_t rowbase = (size_t)b * SEQ; const int q0 = qb * 256;
    constexpr int BUFB = 9216 + 9216 + 256;
    float* wminL = (float*)(lds + 2 * BUFB);
    const int qg = q0 + 32 * w + r32;
    bf16x8 qr[4];
    { const bf16_t* qp = Qg + (rowbase + qg) * 1024 + h * 64 + 8 * hi;
#pragma unroll
      for (int d0 = 0; d0 < 4; ++d0) qr[d0] = *(const bf16x8*)(qp + 16 * d0); }
    const float* cxs = CX + (size_t)bh * SEQ; const float cref = cxs[q0];
    float m = -1e30f, l = 0.f; f32x16 o0 = {}, o1 = {};
    const int NT = 4 * (qb + 1);
    const int kvK = tid >> 3, segK = tid & 7;
    const bf16_t* kgp = Kg + (rowbase + kvK) * 1024 + h * 64 + 8 * segK;
    const bf16_t* vgp = Vg + (rowbase + lane) * 1024 + h * 64 + 8 * w;
    u32x4 kreg, vreg; float creg = 0.f;
    int jt = NT - 1;
    kreg = *(const u32x4*)(kgp + (size_t)jt * 64 * 1024); vreg = *(const u32x4*)(vgp + (size_t)jt * 64 * 1024); if (tid < 64) creg = cref - cxs[jt * 64 + tid];
    int cur = 0;
    {
        unsigned char* B = lds; *(u32x4*)(B + kvK * 144 + 16 * segK) = kreg;
#pragma unroll
        for (int e = 0; e < 4; ++e) { *(bf16_t*)(B + 9216 + (8 * w + 2 * e) * 144 + 2 * lane) = (bf16_t)(vreg[e] & 0xffffu); *(bf16_t*)(B + 9216 + (8 * w + 2 * e + 1) * 144 + 2 * lane) = (bf16_t)(vreg[e] >> 16); }
        if (tid < 64) *(float*)(B + 18432 + 4 * tid) = creg;
    }
    __syncthreads();
    for (; jt >= 0; --jt) {
        const bool has_next = jt > 0;
        if (has_next) { kreg = *(const u32x4*)(kgp + (size_t)(jt - 1) * 64 * 1024); vreg = *(const u32x4*)(vgp + (size_t)(jt - 1) * 64 * 1024); if (tid < 64) creg = cref - cxs[(jt - 1) * 64 + tid]; }
        const unsigned char* B = lds + cur * BUFB; const int kv0 = jt * 64;
        if (kv0 <= q0 + 32 * w + 31) {
            f32x16 p0, p1;
            const float* ck = (const float*)(B + 18432);
#pragma unroll
            for (int g = 0; g < 4; ++g) {
                const f32x4 c0 = *(const f32x4*)(ck + 8 * g + 4 * hi), c1 = *(const f32x4*)(ck + 32 + 8 * g + 4 * hi);
                p0[4 * g] = c0[0]; p0[4 * g + 1] = c0[1]; p0[4 * g + 2] = c0[2]; p0[4 * g + 3] = c0[3];
                p1[4 * g] = c1[0]; p1[4 * g + 1] = c1[1]; p1[4 * g + 2] = c1[2]; p1[4 * g + 3] = c1[3];
            }
#pragma unroll
            for (int d0 = 0; d0 < 4; ++d0) {
                const bf16x8 k0f = *(const bf16x8*)(B + r32 * 144 + 32 * d0 + 16 * hi), k1f = *(const bf16x8*)(B + (32 + r32) * 144 + 32 * d0 + 16 * hi);
                p0 = MFMA32(k0f, qr[d0], p0); p1 = MFMA32(k1f, qr[d0], p1);
            }
            if (kv0 + 63 > q0 + 32 * w) {
#pragma unroll
                for (int r = 0; r < 16; ++r) { const int kv = kv0 + crow(r, hi); if (kv > qg) p0[r] = -INFINITY; if (kv + 32 > qg) p1[r] = -INFINITY; }
            }
            float mx = fmaxf(p0[0], p1[0]);
#pragma unroll
            for (int r = 1; r < 16; ++r) mx = fmaxf(mx, fmaxf(p0[r], p1[r]));
            mx = fmaxf(mx, __shfl_xor(mx, 32));
            const float mnew = fmaxf(m, mx), alpha = __builtin_amdgcn_exp2f(m - mnew); m = mnew;
            float ls = 0.f;
#pragma unroll
            for (int r = 0; r < 16; ++r) { p0[r] = __builtin_amdgcn_exp2f(p0[r] - mnew); p1[r] = __builtin_amdgcn_exp2f(p1[r] - mnew); ls += p0[r] + p1[r]; }
            l = l * alpha + ls;
#pragma unroll
            for (int r = 0; r < 16; ++r) { o0[r] *= alpha; o1[r] *= alpha; }
            const unsigned char* Vt = B + 9216;
#pragma unroll
            for (int j2 = 0; j2 < 4; ++j2) {
                const int rr = (j2 & 1) * 8; u32x4 pw;
                if (j2 < 2) { pw.x = pk2(p0[rr], p0[rr + 1]); pw.y = pk2(p0[rr + 2], p0[rr + 3]); pw.z = pk2(p0[rr + 4], p0[rr + 5]); pw.w = pk2(p0[rr + 6], p0[rr + 7]); }
                else { pw.x = pk2(p1[rr], p1[rr + 1]); pw.y = pk2(p1[rr + 2], p1[rr + 3]); pw.z = pk2(p1[rr + 4], p1[rr + 5]); pw.w = pk2(p1[rr + 6], p1[rr + 7]); }
                const bf16x8 pf = __builtin_bit_cast(bf16x8, pw);
                const int kvb = 32 * (j2 >> 1) + 16 * (j2 & 1) + 4 * hi;
#pragma unroll
                for (int dh = 0; dh < 2; ++dh) {
                    const unsigned char* vrow = Vt + (32 * dh + r32) * 144 + 2 * kvb;
                    const u32x2 lo = *(const u32x2*)(vrow), hh = *(const u32x2*)(vrow + 16);
                    const u32x4 vw = {lo.x, lo.y, hh.x, hh.y}; const bf16x8 vf = __builtin_bit_cast(bf16x8, vw);
                    if (dh == 0) o0 = MFMA32(vf, pf, o0); else o1 = MFMA32(vf, pf, o1);
                }
            }
        }
        { float wm = m;
#pragma unroll
          for (int o = 1; o < 32; o <<= 1) wm = fminf(wm, __shfl_xor(wm, o));
          if (lane == 0) wminL[cur * 8 + w] = wm; }
        if (has_next) {
            unsigned char* Bn = lds + (cur ^ 1) * BUFB; *(u32x4*)(Bn + kvK * 144 + 16 * segK) = kreg;
#pragma unroll
            for (int e = 0; e < 4; ++e) { *(bf16_t*)(Bn + 9216 + (8 * w + 2 * e) * 144 + 2 * lane) = (bf16_t)(vreg[e] & 0xffffu); *(bf16_t*)(Bn + 9216 + (8 * w + 2 * e + 1) * 144 + 2 * lane) = (bf16_t)(vreg[e] >> 16); }
            if (tid < 64) *(float*)(Bn + 18432 + 4 * tid) = creg;
        }
        __syncthreads();
        if (has_next) {
            const float* wl = wminL + cur * 8; float bm = fminf(fminf(fminf(wl[0], wl[1]), fminf(wl[2], wl[3])), fminf(fminf(wl[4], wl[5]), fminf(wl[6], wl[7])));
            const float ub = qkb + *(const float*)(lds + (cur ^ 1) * BUFB + 18432 + 4 * 63);
            if (ub < bm - 40.0f) { __syncthreads(); break; }
        }
        cur ^= 1;
    }
    l += __shfl_xor(l, 32);
    const float inv = 1.0f / l;
    const size_t ooff = (rowbase + qg) * 1024 + h * 64 + 4 * hi;
#pragma unroll
    for (int dh = 0; dh < 2; ++dh)
#pragma unroll
        for (int g = 0; g < 4; ++g) {
            const size_t off = ooff + 32 * dh + 8 * g; const u32x2 gg = *(const u32x2*)(Gg + off);
            float a0, a1, a2, a3;
            if (dh == 0) { a0 = o0[4 * g]; a1 = o0[4 * g + 1]; a2 = o0[4 * g + 2]; a3 = o0[4 * g + 3]; } else { a0 = o1[4 * g]; a1 = o1[4 * g + 1]; a2 = o1[4 * g + 2]; a3 = o1[4 * g + 3]; }
            u32x2 ov; ov.x = pk2(a0 * inv * bflo(gg.x), a1 * inv * bfhi(gg.x)); ov.y = pk2(a2 * inv * bflo(gg.y), a3 * inv * bfhi(gg.y));
            *(u32x2*)(Og + off) = ov;
        }
}
__device__ __forceinline__ void fox_attn(unsigned char* lds, const bf16_t* Qg, const bf16_t* Kg, const bf16_t* Vg, const bf16_t* Gg, bf16_t* Og, const float* CX, const float* gq, const float* gk, int blk, int G) {
    float mq = 0.f, mk = 0.f;
    for (int i = 0; i < 64; ++i) { mq = fmaxf(mq, fabsf(gq[i])); mk = fmaxf(mk, fabsf(gk[i])); }
    const float qkb = 64.0f * mq * mk * (0.125f * LOG2E) * 1.02f;
    for (int i = blk; i < 2048; i += G) {
        const int j = i >> 8, vcu = i & 255, s = vcu >> 5, r = vcu & 31, bh = (r + 4 * j) & 31, qb = 8 * j + s;
        fox_attn_unit(lds, Qg, Kg, Vg, Gg, Og, CX, bh, qb, qkb);
    }
}

struct Args { const float* in[13]; float* out; unsigned char* ws; int ph_lo, ph_hi; };
#define PHASE_PTRS() size_t zoff_ = 0; OPQ_S(zoff_); unsigned char* ws = a.ws + zoff_; float* out = a.out + zoff_; \
    float* SSQ = (float*)(ws + WS_SSQ); bf16_t* XB = (bf16_t*)(ws + WS_XB); unsigned char* R = ws + WS_R; (void)SSQ; (void)XB; (void)R; (void)out
#define RUN_PH() (ph >= a.ph_lo && ph < a.ph_hi)
#define SEAM() do { if (ph >= a.ph_lo && ph + 1 < a.ph_hi) { grid_bar((unsigned*)a.ws, nbar, G); ++nbar; } ++ph; } while (0)
#define SEAM_CG() do { if (ph >= a.ph_lo && ph + 1 < a.ph_hi) { asm volatile("s_waitcnt vmcnt(0)" ::: "memory"); __builtin_amdgcn_fence(__ATOMIC_RELEASE, "agent"); cg::this_grid().sync(); __builtin_amdgcn_fence(__ATOMIC_ACQUIRE, "agent"); } ++ph; } while (0)
__device__ __forceinline__ void grid_bar(unsigned* ctr, unsigned nbar, int G) {
    asm volatile("s_waitcnt vmcnt(0) lgkmcnt(0)" ::: "memory");
    __syncthreads();
    if (threadIdx.x == 0) {
        __builtin_amdgcn_fence(__ATOMIC_RELEASE, "agent");
        __hip_atomic_fetch_add(ctr, 1u, __ATOMIC_RELAXED, __HIP_MEMORY_SCOPE_AGENT);
        const unsigned target = (nbar + 1u) * (unsigned)G;
        while (__hip_atomic_load(ctr, __ATOMIC_RELAXED, __HIP_MEMORY_SCOPE_AGENT) < target) __builtin_amdgcn_s_sleep(1);
        __builtin_amdgcn_fence(__ATOMIC_ACQUIRE, "agent");
        asm volatile("s_waitcnt vmcnt(0)" ::: "memory");
    }
    __syncthreads();
}
__global__ void __launch_bounds__(512, 2) mega_fwd(Args a) {
    extern __shared__ __attribute__((aligned(16))) unsigned char lds[];
    const int blk = blockIdx.x, G = gridDim.x; int ph = 0; unsigned nbar = 0;
    __attribute__((address_space(3))) unsigned char* glds = (__attribute__((address_space(3))) unsigned char*)lds;

    if (RUN_PH()) {
        PHASE_PTRS();
        int tid = threadIdx.x; OPQ_V(tid); const int lane = tid & 63, wave = __builtin_amdgcn_readfirstlane(tid >> 6);
        const float* x = a.in[0]; const float* norm_g = a.in[1];
        float* scr = (float*)(lds + wave * 16384);
        const int gw = blk * 8 + wave, NGW = G * 8;
        conv_mats(a.in[2], D, NFI, (bf16_t*)(ws + WS_WFI), NFI, 8, 1, 1, norm_g, scr, gw, NGW, lane);
        conv_mats(a.in[3], DFF, D, (bf16_t*)(ws + WS_WFO), D, 8, 0, 0, norm_g, scr, gw, NGW, lane);
        conv_mats(a.in[4], D, 4096, (bf16_t*)(ws + WS_WHI), 4096, 2, 0, 2, norm_g, scr, gw, NGW, lane);
        conv_mats(a.in[7], D, D, (bf16_t*)(ws + WS_WHO), D, 2, 0, 0, norm_g, scr, gw, NGW, lane);
        conv_mats(a.in[8], D, NXI_SRC, (bf16_t*)(ws + WS_WXI), NXI, 2, 2, 3, norm_g, scr, gw, NGW, lane);
        conv_mats(a.in[12], D, D, (bf16_t*)(ws + WS_WXO), D, 2, 0, 0, norm_g, scr, gw, NGW, lane);
        { bf16_t* WXI = (bf16_t*)(ws + WS_WXI);
          for (int i = blk * 512 + tid; i < 2 * 224 * 128; i += G * 512) { const int mat = i / (224 * 128), r = i % (224 * 128); *(u32x4*)(WXI + (size_t)mat * NXI * D + (size_t)4128 * D + (size_t)r * 8) = (u32x4){0u, 0u, 0u, 0u}; } }
        for (int mrow = gw; mrow < M; mrow += NGW) {
            const f32x4* xr = (const f32x4*)(x + (size_t)mrow * D) + lane; f32x4 v[4]; float s = 0.f;
#pragma unroll
            for (int j = 0; j < 4; ++j) { v[j] = xr[64 * j]; s += pg8::dot4(v[j]); }
            s = wave_sum(s);
            u32x2* o8 = (u32x2*)(XB + (size_t)mrow * D) + lane;
#pragma unroll
            for (int j = 0; j < 4; ++j) { u32x2 p; p.x = pk2(v[j][0], v[j][1]); p.y = pk2(v[j][2], v[j][3]); o8[64 * j] = p; }
            if (lane < 16) SSQ[(size_t)mrow * 16 + lane] = (lane == 0) ? s : 0.f;
        }
        { const float* lg = a.in[5]; float* LB = (float*)(ws + WS_LB);
          for (int i = blk * 512 + tid; i < 1024; i += G * 512) { const float l0 = lg[i], l1 = lg[1024 + i]; LB[i] = 0.f; LB[1024 + i] = 1.0f / (1.0f + __expf(l0 - l1)); } }
    }
    SEAM_CG();

    for (int L = 0; L < 4; ++L) {
        const int j = L >> 1;
        for (int s = 0; s < 2; ++s) {
            if (RUN_PH()) {
                PHASE_PTRS();
                pg8::Gemm g{XB, (bf16_t*)(ws + WS_WFI) + (size_t)(2 * L + s) * NFI * D, M, NFI, D}; pg8::StaticOrder S; S.init(M, NFI, G, blk);
                pg8::EpiSwiglu E{(bf16_t*)(R + R_HID), SSQ, DFF};
#ifndef NO_G1
                pg8::gemm_phase<pg8::EpiSwiglu, pg8::StaticOrder, true, true>(glds, g, S, E);
#endif
            }
            SEAM();
            if (RUN_PH()) {
                PHASE_PTRS();
                pg8::Gemm g{(bf16_t*)(R + R_HID), (bf16_t*)(ws + WS_WFO) + (size_t)(2 * L + s) * D * DFF, M, D, DFF}; pg8::StaticOrder S; S.init(M, D, G, blk);
                const float* base = (L == 0 && s == 0) ? a.in[0] : out;
                pg8::EpiResid E{base, out, XB, SSQ, 0.5f};
#ifndef NO_G2
                pg8::gemm_phase<pg8::EpiResid, pg8::StaticOrder, true, true>(glds, g, S, E);
#endif
            }
            SEAM();
            if (s == 0) {
                if ((L & 1) == 0) {
                    if (RUN_PH()) {
                        PHASE_PTRS();
                        pg8::Gemm g{XB, (bf16_t*)(ws + WS_WHI) + (size_t)j * 4096 * D, M, 4096, D}; pg8::StaticOrder S; S.init(M, 4096, G, blk);
                        pg8::EpiHgrn E{(bf16_t*)(R + R_Q), (float*)(R + R_LF), (const float*)(ws + WS_LB) + j * 1024, SSQ};
#ifndef NO_G3
                        pg8::gemm_phase<pg8::EpiHgrn, pg8::StaticOrder, true, true>(glds, g, S, E);
#endif
                    }
                    SEAM();
#ifndef NO_HA
                    if (RUN_PH()) { PHASE_PTRS(); hg_pass_a(lds, (const float*)(R + R_LF), (const bf16_t*)(R + R_V), (bf16_t*)(R + R_U), (float*)(ws + WS_DV), blk, G); }
#endif
                    SEAM();
#ifndef NO_HB
                    if (RUN_PH()) { PHASE_PTRS(); hg_pass_b((bf16_t*)(R + R_U), (const float*)(ws + WS_DV), blk, G); }
#endif
                    SEAM();
#ifndef NO_HC
                    if (RUN_PH()) { PHASE_PTRS(); hg_pass_c(lds, (const float*)(R + R_LF), (const bf16_t*)(R + R_Q), (const bf16_t*)(R + R_V), (const bf16_t*)(R + R_G), (const bf16_t*)(R + R_U), (bf16_t*)(R + R_Q), a.in[6] + j * 128, blk, G); }
#endif
                    SEAM();
                } else {
                    if (RUN_PH()) {
                        PHASE_PTRS();
                        pg8::Gemm g{XB, (bf16_t*)(ws + WS_WXI) + (size_t)j * NXI * D, M, NXI, D}; pg8::StaticOrder S; S.init(M, NXI, G, blk);
                        pg8::EpiFox E{(bf16_t*)(R + RX_Q), (float*)(ws + WS_LFX), a.in[10] + j * 64, a.in[11] + j * 64, a.in[9] + j * 16, SSQ};
#ifndef NO_G5
                        pg8::gemm_phase<pg8::EpiFox, pg8::StaticOrder, true, true>(glds, g, S, E);
#endif
                    }
                    SEAM();
#ifndef NO_FS
                    if (RUN_PH()) { PHASE_PTRS(); fox_scan(lds, (const float*)(ws + WS_LFX), (float*)(ws + WS_CX), blk, G); }
#endif
                    SEAM();
#ifndef NO_FA
                    if (RUN_PH()) { PHASE_PTRS(); fox_attn(lds, (const bf16_t*)(R + RX_Q), (const bf16_t*)(R + RX_K), (const bf16_t*)(R + RX_V), (const bf16_t*)(R + RX_G), (bf16_t*)(R + RX_Q), (const float*)(ws + WS_CX), a.in[10] + j * 64, a.in[11] + j * 64, blk, G); }
#endif
                    SEAM();
                }
                if (RUN_PH()) {
                    PHASE_PTRS();
                    const bf16_t* Wt = ((L & 1) == 0) ? ((bf16_t*)(ws + WS_WHO) + (size_t)j * D * D) : ((bf16_t*)(ws + WS_WXO) + (size_t)j * D * D);
                    pg8::Gemm g{(bf16_t*)(R + R_Q), Wt, M, D, D}; pg8::StaticOrder S; S.init(M, D, G, blk);
                    pg8::EpiResid E{out, out, XB, SSQ, 1.0f};
#ifndef NO_G2
                    pg8::gemm_phase<pg8::EpiResid, pg8::StaticOrder, true, true>(glds, g, S, E);
#endif
                }
                SEAM();
            }
        }
    }
}


#if MK_DIAG == 1
__global__ void diag_bits(float* out, int n) { for (int i = blockIdx.x * blockDim.x + threadIdx.x; i < n; i += gridDim.x * blockDim.x) { const unsigned b = __float_as_uint(out[i]); const bool bad = ((b >> 23) & 0xffu) == 0xffu; out[i] = bad ? 77.0f : (float)(b & 0xffffu) * (1.0f / 65536.0f); } }
#endif

#if MK_DIAG == 2
__global__ void diag_scan(const unsigned* p, size_t nwords, int is_bf16, unsigned* flag, unsigned bit) {
    bool bad = false;
    for (size_t i = (size_t)blockIdx.x * blockDim.x + threadIdx.x; i < nwords; i += (size_t)gridDim.x * blockDim.x) {
        const unsigned w = p[i];
        if (is_bf16) bad |= ((w & 0x7f80u) == 0x7f80u) || ((w & 0x7f800000u) == 0x7f800000u); else bad |= ((w & 0x7f800000u) == 0x7f800000u);
    }
    if (bad) atomicOr(flag, bit);
}
__global__ void diag_emit(float* out, int n, const unsigned* flag) { const float v = 1000.0f * (10.0f + (float)flag[0]); for (int i = blockIdx.x * blockDim.x + threadIdx.x; i < n; i += gridDim.x * blockDim.x) out[i] = (i == 0) ? v : 0.f; }
#endif
extern "C" void kernel_launch(void* const* d_in, const int* in_sizes, int n_in, void* d_out, int out_size, void* d_ws, size_t ws_size, hipStream_t stream) {
    static int grid = 0;
    if (grid == 0) {
        if (n_in != 13 || out_size != M * D || ws_size < WS_END) { fprintf(stderr, "kernel_launch: unexpected problem (n_in %d out %d ws %zu)\n", n_in, out_size, ws_size); grid = -1; return; }
        int dev = 0, cus = 0, per_cu = 0;
        hipGetDevice(&dev); hipDeviceGetAttribute(&cus, hipDeviceAttributeMultiprocessorCount, dev);
        hipFuncSetAttribute((const void*)mega_fwd, hipFuncAttributeMaxDynamicSharedMemorySize, LDS_BYTES);
        hipOccupancyMaxActiveBlocksPerMultiprocessor(&per_cu, (const void*)mega_fwd, 512, LDS_BYTES);
        if (per_cu < 1) { fprintf(stderr, "kernel_launch: occupancy query says %d blocks per CU\n", per_cu); per_cu = 1; }
        grid = cus * 1;
        (void)hipGetLastError();
    }
    if (grid < 0) return;
    Args a{};
    for (int i = 0; i < 13; ++i) a.in[i] = (const float*)d_in[i];
    a.out = (float*)d_out; a.ws = (unsigned char*)d_ws;
    hipError_t e = hipSuccess;
#if MK_SPLIT
#ifndef MK_STOP
#define MK_STOP N_PHASES
#endif
#if MK_DIAG == 2
    hipMemsetAsync(d_ws, 0, 256, stream);
#endif
    for (int p = 0; p < MK_STOP && e == hipSuccess; ++p) { a.ph_lo = p; a.ph_hi = p + 1; hipLaunchKernelGGL(mega_fwd, dim3(grid), dim3(512), LDS_BYTES, stream, a); e = hipPeekAtLastError(); }
#else
    a.ph_lo = 0; a.ph_hi = N_PHASES;
    if (hipMemsetAsync(d_ws, 0, 256, stream) != hipSuccess) { fprintf(stderr, "kernel_launch: memset of the barrier word failed\n"); return; }
    void* args[] = {&a};
    e = hipLaunchCooperativeKernel((const void*)mega_fwd, dim3(grid), dim3(512), args, LDS_BYTES, stream);
#endif
#if MK_DIAG == 2
    { unsigned char* w8 = (unsigned char*)d_ws; unsigned* flag = (unsigned*)w8;
      const size_t regs[6][3] = MK_REGIONS;
      for (int r = 0; r < 6; ++r) { if (regs[r][1] == 0) continue; const unsigned* p = (regs[r][0] == ~(size_t)0) ? (const unsigned*)d_out : (const unsigned*)(w8 + regs[r][0]);
        hipLaunchKernelGGL(diag_scan, dim3(2048), dim3(256), 0, stream, p, regs[r][1] / 4, (int)regs[r][2], flag, 1u << r); }
      hipLaunchKernelGGL(diag_emit, dim3(2048), dim3(256), 0, stream, (float*)d_out, out_size, (const unsigned*)flag); }
#endif
#if MK_DIAG == 1
    hipLaunchKernelGGL(diag_bits, dim3(2048), dim3(256), 0, stream, (float*)d_out, out_size);
#endif
    if (e != hipSuccess) fprintf(stderr, "kernel_launch: cooperative launch failed: %s (grid %d)\n", hipGetErrorString(e), grid);
}
```
